# Optimizing an MI355X kernel written in HIP

```python
import math
import jax, jax.numpy as jnp
from jax import lax
import numpy as np

D_MODEL = 2048
BATCH = 4
SEQ = 2048
DEPTH = 1
DEC_BATCH = 128
DEC_SEQ = 1
PAST_LEN = 16384
PAGE_SIZE = 128

N_META = 16
NORM_EPS = 1e-5
SSD_WIDTH = D_MODEL
SSD_HEAD_DIM = 64
SSD_HEADS = SSD_WIDTH // SSD_HEAD_DIM
SSD_GROUPS = 4
SSD_HPG = SSD_HEADS // SSD_GROUPS
SSD_STATE = 128
SSD_CONV = 4
SSD_CHUNK = 128
SSD_XBC = SSD_WIDTH + 2 * SSD_GROUPS * SSD_STATE
S5_WIDTH = D_MODEL // 2
S5_GROUP = 16
S5_GROUPS = S5_WIDTH // S5_GROUP
S5_STATE = 64
IN_COLS = SSD_WIDTH + SSD_XBC + SSD_HEADS + 2 * S5_WIDTH + 2 * D_MODEL

kernel_name = "hybrid_ssd_s5_gated_decoder_step"


def _rmsnorm(x, w):
    xf = x.astype(jnp.float32)
    y = xf * lax.rsqrt(jnp.mean(xf * xf, axis=-1, keepdims=True) + NORM_EPS)
    return (y * w.astype(jnp.float32)).astype(x.dtype)


def _split_in(p):
    sizes = (SSD_WIDTH, SSD_XBC, SSD_HEADS, S5_WIDTH, S5_WIDTH, D_MODEL)
    idx, acc = [], 0
    for s in sizes:
        acc += s
        idx.append(acc)
    return jnp.split(p, idx, axis=-1)


def _causal_conv(u, prev, w, b):
    T = u.shape[1]
    up = jnp.concatenate([prev.astype(u.dtype), u], axis=1)
    y = b + up[:, 0:T] * w[0]
    for k in range(1, SSD_CONV):
        y = y + up[:, k:k + T] * w[k]
    return y, up[:, T:]


def _ssd_chunked(x, dt, A, bm, cm, h0):
    bsz, T = x.shape[:2]
    pad = (-T) % SSD_CHUNK
    padt = lambda a: jnp.pad(a, [(0, 0), (pad, 0)] + [(0, 0)] * (a.ndim - 2))
    x, dt, bm, cm = padt(x), padt(dt), padt(bm), padt(cm)
    nc = (T + pad) // SSD_CHUNK
    G, R, P, N, L = SSD_GROUPS, SSD_HPG, SSD_HEAD_DIM, SSD_STATE, SSD_CHUNK
    xd = (x * dt[..., None]).reshape(bsz, nc, L, G, R, P)
    a = (dt * A).reshape(bsz, nc, L, G, R)
    bc = bm.reshape(bsz, nc, L, G, N)
    cc = cm.reshape(bsz, nc, L, G, N)
    a_cum = jnp.cumsum(a, axis=2)
    seg = a_cum[:, :, :, None] - a_cum[:, :, None, :]
    causal = jnp.tril(jnp.ones((L, L), dtype=bool))[None, None, :, :, None, None]
    decay_ls = jnp.exp(jnp.where(causal, seg, -jnp.inf))
    cb = jnp.einsum('bclgn,bcsgn->bclsg', cc, bc)
    y_diag = jnp.einsum('bclsg,bclsgr,bcsgrp->bclgrp', cb, decay_ls, xd)
    decay_end = jnp.exp(a_cum[:, :, -1:] - a_cum)
    chunk_states = jnp.einsum('bclgn,bclgr,bclgrp->bcgrpn', bc, decay_end, xd)
    chunk_decay = jnp.exp(a_cum[:, :, -1])

    def step(h, inp):
        s_c, d_c = inp
        return d_c[..., None, None] * h + s_c, h

    h_last, h_in = lax.scan(step, h0.reshape(bsz, G, R, P, N),
                            (jnp.moveaxis(chunk_states, 1, 0), jnp.moveaxis(chunk_decay, 1, 0)))
    h_in = jnp.moveaxis(h_in, 0, 1)
    y_off = jnp.einsum('bclgn,bcgrpn,bclgr->bclgrp', cc, h_in, jnp.exp(a_cum))
    y = (y_diag + y_off).reshape(bsz, nc * L, G * R, P)[:, pad:]
    return y, h_last.reshape(bsz, G * R, P, N)


def _complex_affine_combine(e1, e2):
    a1r, a1i, b1r, b1i = e1
    a2r, a2i, b2r, b2i = e2
    return (a2r * a1r - a2i * a1i,
            a2r * a1i + a2i * a1r,
            a2r * b1r - a2i * b1i + b2r,
            a2r * b1i + a2i * b1r + b2i)


def _s5_scan(u, h0_re, h0_im, lam_re, lam_im, log_dt, b_re, b_im, c_re, c_im, d_skip):
    bsz, T, _ = u.shape
    f32 = jnp.float32
    uf = u.astype(f32)
    ug = uf.reshape(bsz, T, S5_GROUPS, S5_GROUP)
    lr, li = lam_re.astype(f32), lam_im.astype(f32)
    step = jnp.exp(log_dt.astype(f32))[:, None]
    mag = jnp.exp(lr * step)
    ab_re, ab_im = mag * jnp.cos(li * step), mag * jnp.sin(li * step)
    den = lr * lr + li * li
    num_re = ab_re - 1.0
    coef_re = (num_re * lr + ab_im * li) / den
    coef_im = (ab_im * lr - num_re * li) / den
    br, bi = b_re.astype(f32), b_im.astype(f32)
    bbar_re = coef_re[..., None] * br - coef_im[..., None] * bi
    bbar_im = coef_re[..., None] * bi + coef_im[..., None] * br
    bu_re = jnp.einsum('btgc,gnc->btgn', ug, bbar_re)
    bu_im = jnp.einsum('btgc,gnc->btgn', ug, bbar_im)
    h0r, h0i = h0_re.astype(f32), h0_im.astype(f32)
    bu_re = bu_re.at[:, 0].add(ab_re * h0r - ab_im * h0i)
    bu_im = bu_im.at[:, 0].add(ab_re * h0i + ab_im * h0r)
    a_re = jnp.broadcast_to(ab_re, bu_re.shape)
    a_im = jnp.broadcast_to(ab_im, bu_im.shape)
    _, _, h_re, h_im = lax.associative_scan(_complex_affine_combine, (a_re, a_im, bu_re, bu_im), axis=1)
    y = (jnp.einsum('gcn,btgn->btgc', c_re.astype(f32), h_re)
         - jnp.einsum('gcn,btgn->btgc', c_im.astype(f32), h_im))
    y = y.reshape(bsz, T, S5_WIDTH) + d_skip.astype(f32) * uf
    return y, h_re[:, -1], h_im[:, -1]


def _layer(h, ssd_h0, conv_prev, s5_re0, s5_im0, norm_w, w_in, conv_w, conv_b, dt_bias, a_log,
           d_ssd, ssd_norm_w, w_proj_a, lam_re, lam_im, log_dt_s5, b_re, b_im, c_re, c_im,
           d_s5, w_glu, b_glu, w_proj_b, w_out):
    f32 = jnp.float32
    bsz, T, _ = h.shape
    xn = _rmsnorm(h, norm_w)
    proj = xn @ w_in
    z_a, xbc, dt_raw, u_b, z_b, g_a, g_b = _split_in(proj)
    xbc, conv_new = _causal_conv(xbc, conv_prev, conv_w, conv_b)
    xbc = jax.nn.silu(xbc)
    xs, bm, cm = jnp.split(xbc, [SSD_WIDTH, SSD_WIDTH + SSD_GROUPS * SSD_STATE], axis=-1)
    xs_h = xs.astype(f32).reshape(bsz, T, SSD_HEADS, SSD_HEAD_DIM)
    dt = jax.nn.softplus(dt_raw.astype(f32) + dt_bias.astype(f32))
    A = -jnp.exp(a_log.astype(f32))
    y, ssd_new = _ssd_chunked(xs_h, dt, A,
                              bm.astype(f32).reshape(bsz, T, SSD_GROUPS, SSD_STATE),
                              cm.astype(f32).reshape(bsz, T, SSD_GROUPS, SSD_STATE),
                              ssd_h0.astype(f32))
    y = y + d_ssd.astype(f32)[:, None] * xs_h
    y = y.reshape(bsz, T, SSD_WIDTH) * jax.nn.silu(z_a.astype(f32))
    yg = y.reshape(bsz, T, SSD_GROUPS, SSD_WIDTH // SSD_GROUPS)
    yg = yg * lax.rsqrt(jnp.mean(yg * yg, axis=-1, keepdims=True) + NORM_EPS)
    y = yg.reshape(bsz, T, SSD_WIDTH) * ssd_norm_w.astype(f32)
    ya = y.astype(h.dtype) @ w_proj_a
    yb, s5r, s5i = _s5_scan(u_b, s5_re0, s5_im0, lam_re, lam_im, log_dt_s5, b_re, b_im,
                            c_re, c_im, d_s5)
    yb = jax.nn.gelu(yb).astype(h.dtype)
    yb = yb * jax.nn.sigmoid(yb @ w_glu + b_glu) * jax.nn.silu(z_b)
    yb = yb @ w_proj_b
    mixed = jax.nn.sigmoid(g_a) * ya + jax.nn.sigmoid(g_b) * yb
    out = h + mixed @ w_out
    return out, ssd_new.astype(h.dtype), conv_new, s5r.astype(h.dtype), s5i.astype(h.dtype)


def setup_inputs(seed: int = 0) -> dict:
    key = jax.random.key(seed)
    ks = jax.random.split(key, 32)
    f32 = jnp.float32
    nrm = lambda k, shape, s: jax.random.normal(k, shape, f32) * s
    dt0 = jnp.exp(jax.random.uniform(ks[10], (DEPTH, SSD_HEADS), f32, math.log(1e-3), math.log(1e-1)))
    n_idx = jnp.arange(S5_STATE, dtype=f32)
    return {
        "x_prompt": nrm(ks[0], (BATCH, SEQ, D_MODEL), 1.0),
        "x_sample": nrm(ks[1], (DEC_BATCH, DEC_SEQ, D_MODEL), 1.0),
        "state_ssd": nrm(ks[2], (DEPTH, DEC_BATCH, SSD_HEADS, SSD_HEAD_DIM, SSD_STATE), 0.3),
        "state_conv": nrm(ks[3], (DEPTH, DEC_BATCH, SSD_CONV - 1, SSD_XBC), 1.0),
        "state_s5_re": nrm(ks[4], (DEPTH, DEC_BATCH, S5_GROUPS, S5_STATE), 0.3),
        "state_s5_im": nrm(ks[5], (DEPTH, DEC_BATCH, S5_GROUPS, S5_STATE), 0.3),
        "meta_tokens": nrm(ks[6], (N_META, D_MODEL), 1.0),
        "norm_w": 1.0 + nrm(ks[7], (DEPTH, D_MODEL), 0.01),
        "w_in": nrm(ks[8], (DEPTH, D_MODEL, IN_COLS), D_MODEL ** -0.5),
        "conv_w": nrm(ks[9], (DEPTH, SSD_CONV, SSD_XBC), SSD_CONV ** -0.5),
        "conv_b": nrm(ks[11], (DEPTH, SSD_XBC), 0.01),
        "dt_bias": dt0 + jnp.log(-jnp.expm1(-dt0)),
        "a_log": jnp.log(jax.random.uniform(ks[12], (DEPTH, SSD_HEADS), f32, 1.0, 16.0)),
        "d_ssd": 1.0 + nrm(ks[13], (DEPTH, SSD_HEADS), 0.01),
        "ssd_norm_w": 1.0 + nrm(ks[14], (DEPTH, SSD_WIDTH), 0.01),
        "w_proj_a": nrm(ks[15], (DEPTH, SSD_WIDTH, D_MODEL), SSD_WIDTH ** -0.5),
        "lam_re": -0.5 + nrm(ks[16], (DEPTH, S5_GROUPS, S5_STATE), 0.01),
        "lam_im": math.pi * n_idx + nrm(ks[17], (DEPTH, S5_GROUPS, S5_STATE), 0.01),
        "log_dt_s5": jax.random.uniform(ks[18], (DEPTH, S5_GROUPS), f32, math.log(1e-3), math.log(1e-1)),
        "b_re": nrm(ks[19], (DEPTH, S5_GROUPS, S5_STATE, S5_GROUP), (2 * S5_GROUP) ** -0.5),
        "b_im": nrm(ks[20], (DEPTH, S5_GROUPS, S5_STATE, S5_GROUP), (2 * S5_GROUP) ** -0.5),
        "c_re": nrm(ks[21], (DEPTH, S5_GROUPS, S5_GROUP, S5_STATE), (2 * S5_STATE) ** -0.5),
        "c_im": nrm(ks[22], (DEPTH, S5_GROUPS, S5_GROUP, S5_STATE), (2 * S5_STATE) ** -0.5),
        "d_s5": nrm(ks[23], (DEPTH, S5_WIDTH), 1.0),
        "w_glu": nrm(ks[24], (DEPTH, S5_WIDTH, S5_WIDTH), S5_WIDTH ** -0.5),
        "b_glu": nrm(ks[25], (DEPTH, S5_WIDTH), 0.01),
        "w_proj_b": nrm(ks[26], (DEPTH, S5_WIDTH, D_MODEL), S5_WIDTH ** -0.5),
        "w_out": nrm(ks[27], (DEPTH, D_MODEL, D_MODEL), D_MODEL ** -0.5),
        "final_norm_w": 1.0 + nrm(ks[28], (D_MODEL,), 0.01),
    }


def reference(x_prompt, x_sample, state_ssd, state_conv, state_s5_re, state_s5_im, meta_tokens,
              norm_w, w_in, conv_w, conv_b, dt_bias, a_log, d_ssd, ssd_norm_w, w_proj_a,
              lam_re, lam_im, log_dt_s5, b_re, b_im, c_re, c_im, d_s5, w_glu, b_glu, w_proj_b,
              w_out, final_norm_w):
    bp = x_prompt.shape[0]
    meta = jnp.broadcast_to(meta_tokens.astype(x_prompt.dtype)[None], (bp, N_META, D_MODEL))
    hp = jnp.concatenate([meta, x_prompt], axis=1)
    hs = x_sample
    ssd_p, conv_p, re_p, im_p = [], [], [], []
    ssd_s, conv_s, re_s, im_s = [], [], [], []
    for i in range(DEPTH):
        lw = (norm_w[i], w_in[i], conv_w[i], conv_b[i], dt_bias[i], a_log[i], d_ssd[i],
              ssd_norm_w[i], w_proj_a[i], lam_re[i], lam_im[i], log_dt_s5[i], b_re[i], b_im[i],
              c_re[i], c_im[i], d_s5[i], w_glu[i], b_glu[i], w_proj_b[i], w_out[i])
        zs = jnp.zeros((bp, SSD_HEADS, SSD_HEAD_DIM, SSD_STATE), hp.dtype)
        zc = jnp.zeros((bp, SSD_CONV - 1, SSD_XBC), hp.dtype)
        z5 = jnp.zeros((bp, S5_GROUPS, S5_STATE), hp.dtype)
        hp, a1, a2, a3, a4 = _layer(hp, zs, zc, z5, z5, *lw)
        hs, s1, s2, s3, s4 = _layer(hs, state_ssd[i], state_conv[i], state_s5_re[i],
                                    state_s5_im[i], *lw)
        ssd_p.append(a1); conv_p.append(a2); re_p.append(a3); im_p.append(a4)
        ssd_s.append(s1); conv_s.append(s2); re_s.append(s3); im_s.append(s4)
    y_prompt = _rmsnorm(hp, final_norm_w)[:, N_META:]
    y_sample = _rmsnorm(hs, final_norm_w)
    return (y_prompt, y_sample, jnp.stack(ssd_p), jnp.stack(conv_p), jnp.stack(re_p), jnp.stack(im_p),
            jnp.stack(ssd_s), jnp.stack(conv_s), jnp.stack(re_s), jnp.stack(im_s))
```

```cpp
#include <hip/hip_runtime.h>
#include <hip/hip_cooperative_groups.h>
#include <cstdio>
namespace cg = cooperative_groups;

#ifndef ONE_LAUNCH
#define ONE_LAUNCH 1
#endif

#define LAS __attribute__((address_space(3)))
typedef unsigned short bf16_t;
typedef short bf16x8 __attribute__((ext_vector_type(8)));
typedef float f32x4 __attribute__((ext_vector_type(4)));
typedef float f32x2 __attribute__((ext_vector_type(2)));
typedef unsigned u32x4 __attribute__((ext_vector_type(4)));
typedef unsigned u32x2 __attribute__((ext_vector_type(2)));

constexpr int MP = 8448;
constexpr int NPROJ = 11520;
constexpr int C_ZA = 0, C_XBC = 2048, C_UB = 5120, C_ZB = 6144, C_GA = 7168, C_GB = 9216, C_DT = 11264;
constexpr int LDS_BYTES = 139264;

constexpr size_t O_YP = 0, O_YS = 16777216, O_SSDP = 17039360, O_CONVP = 18087936, O_S5RP = 18124800, O_S5IP = 18141184,
                 O_SSDS = 18157568, O_CONVS = 51712000, O_S5RS = 52891648, O_S5IS = 53415936;

constexpr size_t WS_CTL = 0;
constexpr size_t WS_ROWSQ = 4096;
constexpr size_t WS_GSQ = WS_ROWSQ + 36864;
constexpr size_t WS_DT = WS_GSQ + 135168;
constexpr size_t WS_WTIN = WS_DT + 1081344;
constexpr size_t WS_WTA = WS_WTIN + (size_t)NPROJ * 2048 * 2;
constexpr size_t WS_WTGLU = WS_WTA + (size_t)2048 * 2048 * 2;
constexpr size_t WS_WTB = WS_WTGLU + (size_t)1024 * 1024 * 2;
constexpr size_t WS_WTOUT = WS_WTB + (size_t)2048 * 1024 * 2;
constexpr size_t WS_R1 = WS_WTOUT + (size_t)2048 * 2048 * 2;
constexpr size_t WS_R2 = WS_R1 + (size_t)MP * 2048 * 2;
constexpr size_t WS_R3 = WS_R2 + (size_t)MP * 2048 * 2;
constexpr size_t WS_PROJ = WS_R3 + (size_t)MP * 2048 * 2;
constexpr size_t WS_BN = WS_PROJ + (size_t)MP * NPROJ * 2;
constexpr size_t WS_CN = WS_BN + (size_t)MP * 512 * 2;
constexpr size_t WS_BT = WS_CN + (size_t)MP * 512 * 2;
constexpr size_t WS_YB = WS_BT + (size_t)MP * 512 * 2;
constexpr size_t WS_YB2 = WS_YB + (size_t)MP * 1024 * 2;
constexpr size_t WS_END = WS_YB2 + (size_t)MP * 1024 * 2;

struct Params {
    const float* in[29];
    float* out;
    unsigned char* ws;
};
typedef const __attribute__((address_space(4))) Params* PP;

__device__ __forceinline__ float bf2f(bf16_t b) { return __uint_as_float(((unsigned)b) << 16); }
__device__ __forceinline__ bf16_t f2bf(float f) { unsigned u = __float_as_uint(f); u += 0x7FFFu + ((u >> 16) & 1u); return (bf16_t)(u >> 16); }
__device__ __forceinline__ unsigned cvt_pk_bf16(float lo, float hi) { unsigned r; asm volatile("v_cvt_pk_bf16_f32 %0, %1, %2" : "=v"(r) : "v"(lo), "v"(hi)); return r; }
__device__ __forceinline__ float lo_bf(unsigned w) { return __uint_as_float(w << 16); }
__device__ __forceinline__ float hi_bf(unsigned w) { return __uint_as_float(w & 0xffff0000u); }
__device__ __forceinline__ float sigmoidf_(float x) { return __builtin_amdgcn_rcpf(1.0f + __expf(-x)); }
__device__ __forceinline__ float siluf_(float x) { return x * sigmoidf_(x); }
__device__ __forceinline__ float gelu_tanh(float x) {
    const float u = 0.7978845608028654f * (x + 0.044715f * x * x * x);
    const float e = __expf(2.0f * u);
    const float t = 1.0f - 2.0f * __builtin_amdgcn_rcpf(1.0f + e);
    return 0.5f * x * (1.0f + t);
}
__device__ __forceinline__ float softplusf_(float x) { return fmaxf(x, 0.0f) + log1pf(__expf(-fabsf(x))); }
__device__ __forceinline__ int prow(int b, int tp) { return tp < 16 ? (8320 + tp) : (b * 2048 + tp - 16); }

__device__ __forceinline__ double d_exp(double x) {
    const double kf = __builtin_rint(x * 1.4426950408889634);
    const double r = (x - kf * 0.693147180369123816490e+00) - kf * 1.90821492927058770002e-10;
    double s = 1.0 / 6227020800.0;
    s = s * r + 1.0 / 479001600.0;
    s = s * r + 1.0 / 39916800.0;
    s = s * r + 1.0 / 3628800.0;
    s = s * r + 1.0 / 362880.0;
    s = s * r + 1.0 / 40320.0;
    s = s * r + 1.0 / 5040.0;
    s = s * r + 1.0 / 720.0;
    s = s * r + 1.0 / 120.0;
    s = s * r + 1.0 / 24.0;
    s = s * r + 1.0 / 6.0;
    s = s * r + 0.5;
    s = s * r + 1.0;
    s = s * r + 1.0;
    const long long bits = ((long long)((int)kf + 1023)) << 52;
    return s * __longlong_as_double(bits);
}
__device__ __forceinline__ void d_sincos(double x, double& sn, double& cs) {
    const double kf = __builtin_rint(x * 0.63661977236758134308);
    const double y = (x - kf * 1.57079632673412561417e+00) - kf * 6.07710050650619224932e-11;
    const double y2 = y * y;
    double ps = -1.0 / 1307674368000.0;
    ps = ps * y2 + 1.0 / 6227020800.0;
    ps = ps * y2 - 1.0 / 39916800.0;
    ps = ps * y2 + 1.0 / 362880.0;
    ps = ps * y2 - 1.0 / 5040.0;
    ps = ps * y2 + 1.0 / 120.0;
    ps = ps * y2 - 1.0 / 6.0;
    ps = ps * y2 + 1.0;
    const double s0 = y * ps;
    double pc = 1.0 / 20922789888000.0;
    pc = pc * y2 - 1.0 / 87178291200.0;
    pc = pc * y2 + 1.0 / 479001600.0;
    pc = pc * y2 - 1.0 / 3628800.0;
    pc = pc * y2 + 1.0 / 40320.0;
    pc = pc * y2 - 1.0 / 720.0;
    pc = pc * y2 + 1.0 / 24.0;
    pc = pc * y2 - 0.5;
    pc = pc * y2 + 1.0;
    const int q = ((int)kf) & 3;
    sn = (q == 0) ? s0 : (q == 1) ? pc : (q == 2) ? -s0 : -pc;
    cs = (q == 0) ? pc : (q == 1) ? -s0 : (q == 2) ? -pc : s0;
}

namespace pg8 {
constexpr int BM = 256, BK = 64, HALF = 128, HTB = HALF * BK * 2, STAGE_BYTES = 8 * HTB, NXCD = 8, WGM = 8;
__device__ __forceinline__ int lds_byte(int r, int c) { const int st = (r >> 4) * 2 + (c >> 5), rr = r & 15, cc = c & 31, ob = rr * 64 + cc * 2; return st * 1024 + (ob ^ (((ob >> 9) & 1) << 5)); }
__device__ __forceinline__ void stage_rc(int b, int& R, int& C) { const int st = b / 1024, sb = b % 1024, swz = sb ^ (((sb >> 9) & 1) << 5); R = (st >> 1) * 16 + swz / 64; C = (st & 1) * 32 + (swz % 64) / 2; }
__device__ __forceinline__ int perm32(int rho) { const int n = rho >> 4, i = rho & 15; return 8 * (i >> 2) + 4 * n + (i & 3); }
struct Unit { int pm, pn; };
struct Gemm { const bf16_t* A; const bf16_t* Bt; int M, N, K; };
struct StaticOrder {
    int nM, nN, nwg, G, c;
    __device__ void init(int M, int N, int G_, int c_) { nM = M / BM; nN = N / BM; nwg = nM * nN; G = G_; c = c_; }
    __device__ bool next(int i, Unit& u) const {
        const long L = (long)i * G + c; if (L >= nwg) return false;
        int wgid = (int)L; { const int q = nwg / NXCD, r = nwg % NXCD, xcd = wgid % NXCD, off = wgid / NXCD; wgid = (xcd < r ? xcd * (q + 1) : r * (q + 1) + (xcd - r) * q) + off; }
        const int nig = WGM * nN, gid = wgid / nig, fm = gid * WGM, gsz = (nM - fm) < WGM ? (nM - fm) : WGM;
        u.pm = fm + ((wgid % nig) % gsz); u.pn = (wgid % nig) / gsz; return true;
    }
};
template <class Epi, class Sched>
__device__ __forceinline__ void gemm_phase(LAS unsigned char* lds, const Gemm g, const Sched& S, const Epi& E, const int tid) {
    const int wid = __builtin_amdgcn_readfirstlane(tid >> 6), lane = tid & 63, wr = wid >> 2, wc = wid & 3, fr = lane & 15, fq = lane >> 4;
    const int K = g.K, nt = K / BK;
    unsigned voffA[2], voffB[2];
#pragma unroll
    for (int i = 0; i < 2; ++i) { int R, C; stage_rc(tid * 16 + i * 8192, R, C); const int Rb = Epi::PERM ? ((R & ~31) + perm32(R & 31)) : R;
        voffA[i] = (unsigned)(R * K + C) * 2u; voffB[i] = (unsigned)(Rb * K + C) * 2u; }
    const size_t kstep = (size_t)(BK * 2);
    const size_t hstep = (size_t)HALF * K * 2;
    const size_t tstep = 2 * hstep;
    const unsigned ldsw = (unsigned)wid * 1024u;
    const int aoff = lds_byte(wr * 64 + fr, fq * 8), boff = lds_byte(wc * 32 + fr, fq * 8);
#define PG8_SA(b, h) (((b) * 2 + (h)) * HTB)
#define PG8_SB(b, h) ((4 + (b) * 2 + (h)) * HTB)
#define PG8_STAGE(bufoff, gbase, voff) do { _Pragma("unroll") for (int _i = 0; _i < 2; ++_i) \
        __builtin_amdgcn_global_load_lds((const unsigned*)((const char*)(gbase) + (voff)[_i]), (LAS unsigned*)(lds + (bufoff) + ldsw + _i * 8192), 16, 0, 0); } while (0)
#define PG8_LDA(dst, b, h) do { _Pragma("unroll") for (int m = 0; m < 4; ++m) _Pragma("unroll") for (int k = 0; k < 2; ++k) dst[m][k] = *(const LAS bf16x8*)(lds + PG8_SA(b, h) + aoff + m * 2048 + k * 1024); } while (0)
#define PG8_LDB(dst, b, h) do { _Pragma("unroll") for (int n = 0; n < 2; ++n) _Pragma("unroll") for (int k = 0; k < 2; ++k) dst[n][k] = *(const LAS bf16x8*)(lds + PG8_SB(b, h) + boff + n * 2048 + k * 1024); } while (0)
#define PG8_MMA(ai, bj, At, Bt) do { __builtin_amdgcn_s_setprio(1); _Pragma("unroll") for (int m = 0; m < 4; ++m) _Pragma("unroll") for (int n = 0; n < 2; ++n) _Pragma("unroll") for (int k = 0; k < 2; ++k) \
        acc[ai][bj][m][n] = __builtin_amdgcn_mfma_f32_16x16x32_bf16(Bt[n][k], At[m][k], acc[ai][bj][m][n], 0, 0, 0); __builtin_amdgcn_s_setprio(0); } while (0)
#define PG8_WAIT_V(n) asm volatile("s_waitcnt vmcnt(" #n ")" ::: "memory")
#define PG8_WAIT_L(n) asm volatile("s_waitcnt lgkmcnt(" #n ")" ::: "memory")
#define PG8_BAR __builtin_amdgcn_s_barrier()
#define PG8_SCHED __builtin_amdgcn_sched_barrier(0)
    Unit cur, nxt; int ui = 0;
    if (!S.next(0, cur)) return;
    f32x4 acc[2][2][4][2];
#pragma unroll
    for (int a = 0; a < 2; ++a)
#pragma unroll
        for (int b = 0; b < 2; ++b)
#pragma unroll
            for (int m = 0; m < 4; ++m)
#pragma unroll
                for (int n = 0; n < 2; ++n) acc[a][b][m][n] = (f32x4){0.f, 0.f, 0.f, 0.f};
    bf16x8 At[4][2], B0[2][2], B1[2][2];
    const char* cA = (const char*)g.A + (size_t)cur.pm * tstep; const char* cB = (const char*)g.Bt + (size_t)cur.pn * tstep;
    PG8_STAGE(PG8_SB(0, 0), cB, voffB); PG8_STAGE(PG8_SA(0, 0), cA, voffA); PG8_STAGE(PG8_SB(0, 1), cB + hstep, voffB); PG8_STAGE(PG8_SA(0, 1), cA + hstep, voffA);
    if (wr == 1) PG8_BAR;
    PG8_WAIT_V(4); PG8_BAR;
    PG8_STAGE(PG8_SB(1, 0), cB + kstep, voffB); PG8_STAGE(PG8_SA(1, 0), cA + kstep, voffA); PG8_STAGE(PG8_SB(1, 1), cB + hstep + kstep, voffB);
    PG8_WAIT_V(6); PG8_BAR;
    for (;;) {
        const bool has_next = S.next(ui + 1, nxt);
        const char* nA = has_next ? (const char*)g.A + (size_t)nxt.pm * tstep : cA; const char* nB = has_next ? (const char*)g.Bt + (size_t)nxt.pn * tstep : cB;
        for (int t = 0; t < nt; t += 2) {
            const bool last = (t == nt - 2);
            const char* a1 = cA + (size_t)(t + 1) * kstep;
            const char* a2 = last ? nA : cA + (size_t)(t + 2) * kstep; const char* b2 = last ? nB : cB + (size_t)(t + 2) * kstep;
            const char* a3 = a2 + kstep; const char* b3 = b2 + kstep;
            PG8_LDB(B0, 0, 0); PG8_SCHED; PG8_LDA(At, 0, 0); PG8_STAGE(PG8_SA(1, 1), a1 + hstep, voffA);
            PG8_WAIT_L(8); PG8_BAR; PG8_WAIT_L(0); PG8_MMA(0, 0, At, B0); PG8_BAR; PG8_SCHED;
            PG8_LDB(B1, 0, 1); PG8_STAGE(PG8_SB(0, 0), b2, voffB);
            PG8_BAR; PG8_WAIT_L(0); PG8_MMA(0, 1, At, B1); PG8_BAR;
            PG8_LDA(At, 0, 1); PG8_STAGE(PG8_SA(0, 0), a2, voffA);
            PG8_BAR; PG8_WAIT_L(0); PG8_MMA(1, 0, At, B0); PG8_BAR; PG8_SCHED;
            PG8_STAGE(PG8_SB(0, 1), b2 + hstep, voffB);
            PG8_WAIT_V(6); PG8_BAR; PG8_MMA(1, 1, At, B1); PG8_BAR;
            PG8_LDB(B0, 1, 0); PG8_SCHED; PG8_LDA(At, 1, 0); PG8_STAGE(PG8_SA(0, 1), a2 + hstep, voffA);
            PG8_WAIT_L(8); PG8_BAR; PG8_WAIT_L(0); PG8_MMA(0, 0, At, B0); PG8_BAR; PG8_SCHED;
            PG8_LDB(B1, 1, 1); PG8_STAGE(PG8_SB(1, 0), b3, voffB);
            PG8_BAR; PG8_WAIT_L(0); PG8_MMA(0, 1, At, B1); PG8_BAR;
            PG8_LDA(At, 1, 1); PG8_STAGE(PG8_SA(1, 0), a3, voffA);
            PG8_BAR; PG8_WAIT_L(0); PG8_MMA(1, 0, At, B0); PG8_BAR; PG8_SCHED;
            PG8_STAGE(PG8_SB(1, 1), b3 + hstep, voffB);
            PG8_WAIT_V(6); PG8_BAR; PG8_MMA(1, 1, At, B1); PG8_BAR;
        }
        E(acc, cur, wr, wc, fr, fq);
        if (!has_next) break;
#pragma unroll
        for (int a = 0; a < 2; ++a)
#pragma unroll
            for (int b = 0; b < 2; ++b)
#pragma unroll
                for (int m = 0; m < 4; ++m)
#pragma unroll
                    for (int n = 0; n < 2; ++n) acc[a][b][m][n] = (f32x4){0.f, 0.f, 0.f, 0.f};
        cur = nxt; cA = nA; cB = nB; ++ui;
    }
    PG8_WAIT_V(0);
    if (wr == 0) PG8_BAR;
    PG8_BAR;
#undef PG8_SA
#undef PG8_SB
#undef PG8_STAGE
#undef PG8_LDA
#undef PG8_LDB
#undef PG8_MMA
#undef PG8_WAIT_V
#undef PG8_WAIT_L
#undef PG8_BAR
#undef PG8_SCHED
}
}
using pg8::Unit;

struct EpiProj {
    static constexpr bool PERM = true;
    bf16_t* O; float* DT;
    __device__ __forceinline__ void operator()(const f32x4 (&acc)[2][2][4][2], const Unit& u, int wr, int wc, int fr, int fq) const {
        const int row0 = u.pm * 256 + wr * 64 + fr, col0 = u.pn * 256 + wc * 32 + 8 * fq;
        const int act = (u.pn < 8 || (u.pn >= 24 && u.pn < 28)) ? 1 : ((u.pn >= 28 && u.pn < 44) ? 2 : 0);
#pragma unroll
        for (int ai = 0; ai < 2; ++ai)
#pragma unroll
            for (int m = 0; m < 4; ++m) {
                const int row = row0 + ai * 128 + m * 16;
                bf16_t* rowp = O + (size_t)row * NPROJ + col0;
#pragma unroll
                for (int bj = 0; bj < 2; ++bj) {
                    f32x4 v0 = acc[ai][bj][m][0], v1 = acc[ai][bj][m][1];
                    if (u.pn == 44 && bj == 0 && wc == 0) { float* d = DT + (size_t)row * 32 + 8 * fq; *(f32x4*)d = v0; *(f32x4*)(d + 4) = v1; }
                    if (act == 1) {
#pragma unroll
                        for (int j = 0; j < 4; ++j) { v0[j] = siluf_(v0[j]); v1[j] = siluf_(v1[j]); }
                    } else if (act == 2) {
#pragma unroll
                        for (int j = 0; j < 4; ++j) { v0[j] = sigmoidf_(v0[j]); v1[j] = sigmoidf_(v1[j]); }
                    }
                    u32x4 w; w.x = cvt_pk_bf16(v0[0], v0[1]); w.y = cvt_pk_bf16(v0[2], v0[3]); w.z = cvt_pk_bf16(v1[0], v1[1]); w.w = cvt_pk_bf16(v1[2], v1[3]);
                    *(u32x4*)(rowp + bj * 128) = w;
                }
            }
    }
};
struct EpiGlu {
    static constexpr bool PERM = true;
    const bf16_t* YB; const bf16_t* PROJ; const float* bias; bf16_t* O;
    __device__ __forceinline__ void operator()(const f32x4 (&acc)[2][2][4][2], const Unit& u, int wr, int wc, int fr, int fq) const {
        const int row0 = u.pm * 256 + wr * 64 + fr, col0 = u.pn * 256 + wc * 32 + 8 * fq;
#pragma unroll
        for (int bj = 0; bj < 2; ++bj) {
            const int col = col0 + bj * 128;
            const f32x4 b0 = *(const f32x4*)(bias + col), b1 = *(const f32x4*)(bias + col + 4);
#pragma unroll
            for (int ai = 0; ai < 2; ++ai)
#pragma unroll
                for (int m = 0; m < 4; ++m) {
                    const int row = row0 + ai * 128 + m * 16;
                    const u32x4 yb = *(const u32x4*)(YB + (size_t)row * 1024 + col);
                    const u32x4 zb = *(const u32x4*)(PROJ + (size_t)row * NPROJ + C_ZB + col);
                    const f32x4 v0 = acc[ai][bj][m][0] + b0, v1 = acc[ai][bj][m][1] + b1;
                    u32x4 w;
                    w.x = cvt_pk_bf16(lo_bf(yb.x) * sigmoidf_(v0[0]) * lo_bf(zb.x), hi_bf(yb.x) * sigmoidf_(v0[1]) * hi_bf(zb.x));
                    w.y = cvt_pk_bf16(lo_bf(yb.y) * sigmoidf_(v0[2]) * lo_bf(zb.y), hi_bf(yb.y) * sigmoidf_(v0[3]) * hi_bf(zb.y));
                    w.z = cvt_pk_bf16(lo_bf(yb.z) * sigmoidf_(v1[0]) * lo_bf(zb.z), hi_bf(yb.z) * sigmoidf_(v1[1]) * hi_bf(zb.z));
                    w.w = cvt_pk_bf16(lo_bf(yb.w) * sigmoidf_(v1[2]) * lo_bf(zb.w), hi_bf(yb.w) * sigmoidf_(v1[3]) * hi_bf(zb.w));
                    *(u32x4*)(O + (size_t)row * 1024 + col) = w;
                    asm volatile("" ::: "memory");
                }
        }
    }
};
template <int SECOND> struct EpiMix {
    static constexpr bool PERM = true;
    const bf16_t* PROJ; const bf16_t* PREV; bf16_t* O;
    __device__ __forceinline__ void operator()(const f32x4 (&acc)[2][2][4][2], const Unit& u, int wr, int wc, int fr, int fq) const {
        const int row0 = u.pm * 256 + wr * 64 + fr, col0 = u.pn * 256 + wc * 32 + 8 * fq;
#pragma unroll
        for (int ai = 0; ai < 2; ++ai)
#pragma unroll
            for (int m = 0; m < 4; ++m) {
                const int row = row0 + ai * 128 + m * 16;
#pragma unroll
                for (int bj = 0; bj < 2; ++bj) {
                    const int col = col0 + bj * 128;
                    const u32x4 gt = *(const u32x4*)(PROJ + (size_t)row * NPROJ + (SECOND ? C_GB : C_GA) + col);
                    const f32x4 v0 = acc[ai][bj][m][0], v1 = acc[ai][bj][m][1];
                    float o[8] = {lo_bf(gt.x) * v0[0], hi_bf(gt.x) * v0[1], lo_bf(gt.y) * v0[2], hi_bf(gt.y) * v0[3],
                                  lo_bf(gt.z) * v1[0], hi_bf(gt.z) * v1[1], lo_bf(gt.w) * v1[2], hi_bf(gt.w) * v1[3]};
                    if (SECOND) {
                        const u32x4 pv = *(const u32x4*)(PREV + (size_t)row * 2048 + col);
                        o[0] += lo_bf(pv.x); o[1] += hi_bf(pv.x); o[2] += lo_bf(pv.y); o[3] += hi_bf(pv.y);
                        o[4] += lo_bf(pv.z); o[5] += hi_bf(pv.z); o[6] += lo_bf(pv.w); o[7] += hi_bf(pv.w);
                    }
                    u32x4 w; w.x = cvt_pk_bf16(o[0], o[1]); w.y = cvt_pk_bf16(o[2], o[3]); w.z = cvt_pk_bf16(o[4], o[5]); w.w = cvt_pk_bf16(o[6], o[7]);
                    *(u32x4*)(O + (size_t)row * 2048 + col) = w;
                    asm volatile("" ::: "memory");
                }
            }
    }
};
struct EpiOut {
    static constexpr bool PERM = false;
    const float* xp; const float* xs; float* out; float* rowsq;
    __device__ __forceinline__ void operator()(const f32x4 (&acc)[2][2][4][2], const Unit& u, int wr, int wc, int fr, int fq) const {
        const int row0 = u.pm * 256 + wr * 64 + fr, col0 = u.pn * 256 + wc * 32 + 4 * fq;
#pragma unroll
        for (int ai = 0; ai < 2; ++ai)
#pragma unroll
            for (int m = 0; m < 4; ++m) {
                const int row = row0 + ai * 128 + m * 16;
                const bool ok = row < 8320;
                const float* hp = row < 8192 ? xp + (size_t)row * 2048 : xs + (size_t)(ok ? row - 8192 : 0) * 2048;
                float s = 0.f;
                if (ok) {
#pragma unroll
                    for (int bj = 0; bj < 2; ++bj)
#pragma unroll
                        for (int n = 0; n < 2; ++n) {
                            const int col = col0 + bj * 128 + n * 16;
                            const f32x4 o = *(const f32x4*)(hp + col) + acc[ai][bj][m][n];
                            *(f32x4*)(out + (size_t)row * 2048 + col) = o;
                            s += o[0] * o[0] + o[1] * o[1] + o[2] * o[2] + o[3] * o[3];
                        }
                }
                s += __shfl_xor(s, 16); s += __shfl_xor(s, 32);
                if (ok && fq == 0) atomicAdd(rowsq + row, s);
            }
    }
};

__device__ __forceinline__ int remap_in(int n) { return n < 5120 ? n : (n < 5152 ? C_DT + (n - 5120) : n - 32); }
__device__ __forceinline__ void phase0(PP p, LAS unsigned char* lds, const int tid) {
    const int bid = blockIdx.x, nb = gridDim.x, wid = tid >> 6, lane = tid & 63;
    {
        float* rowsq = (float*)(p->ws + WS_ROWSQ); float* gsq = (float*)(p->ws + WS_GSQ); unsigned* ctl = (unsigned*)(p->ws + WS_CTL);
        for (int i = bid * 512 + tid; i < MP; i += nb * 512) rowsq[i] = 0.f;
        for (int i = bid * 512 + tid; i < MP * 4; i += nb * 512) gsq[i] = 0.f;
        if (bid == 0 && tid < 64) ctl[tid] = 0u;
    }
    {
        bf16_t* xn = (bf16_t*)(p->ws + WS_R1); const float* nw = p->in[7];
        for (int r = bid * 8 + wid; r < MP; r += nb * 8) {
            const float* src = nullptr;
            if (r < 8192) src = p->in[0] + (size_t)r * 2048;
            else if (r < 8320) src = p->in[1] + (size_t)(r - 8192) * 2048;
            else if (r < 8336) src = p->in[6] + (size_t)(r - 8320) * 2048;
            u32x2* dst = (u32x2*)(xn + (size_t)r * 2048);
            if (!src) {
#pragma unroll
                for (int i = 0; i < 8; ++i) dst[i * 64 + lane] = (u32x2){0u, 0u};
                continue;
            }
            f32x4 v[8]; float ss = 0.f;
#pragma unroll
            for (int i = 0; i < 8; ++i) { v[i] = ((const f32x4*)src)[i * 64 + lane]; ss += v[i][0] * v[i][0] + v[i][1] * v[i][1] + v[i][2] * v[i][2] + v[i][3] * v[i][3]; }
#pragma unroll
            for (int o = 32; o >= 1; o >>= 1) ss += __shfl_xor(ss, o);
            const float rs = rsqrtf(ss * (1.0f / 2048.0f) + 1e-5f);
#pragma unroll
            for (int i = 0; i < 8; ++i) { const f32x4 w = ((const f32x4*)nw)[i * 64 + lane]; u32x2 o; o.x = cvt_pk_bf16(v[i][0] * rs * w[0], v[i][1] * rs * w[1]); o.y = cvt_pk_bf16(v[i][2] * rs * w[2], v[i][3] * rs * w[3]); dst[i * 64 + lane] = o; }
        }
    }
    {
        LAS float* tile = (LAS float*)lds;
        for (int job = bid; job < 8464; job += nb) {
            const float* src; bf16_t* dst; int N, K, nt, kt; bool remap = false; int j = job;
            if (j < 5648) { src = p->in[8]; dst = (bf16_t*)(p->ws + WS_WTIN); N = 11296; K = 2048; nt = j >> 4; kt = j & 15; remap = true; }
            else if ((j -= 5648) < 1024) { src = p->in[15]; dst = (bf16_t*)(p->ws + WS_WTA); N = 2048; K = 2048; nt = j >> 4; kt = j & 15; }
            else if ((j -= 1024) < 256) { src = p->in[24]; dst = (bf16_t*)(p->ws + WS_WTGLU); N = 1024; K = 1024; nt = j >> 3; kt = j & 7; }
            else if ((j -= 256) < 512) { src = p->in[26]; dst = (bf16_t*)(p->ws + WS_WTB); N = 2048; K = 1024; nt = j >> 3; kt = j & 7; }
            else { j -= 512; src = p->in[27]; dst = (bf16_t*)(p->ws + WS_WTOUT); N = 2048; K = 2048; nt = j >> 4; kt = j & 15; }
            const int n0 = nt * 32, k0 = kt * 128;
#pragma unroll
            for (int i = 0; i < 2; ++i) { const int e = tid + i * 512, kr = e >> 3, c4 = e & 7; const f32x4 v = *(const f32x4*)(src + (size_t)(k0 + kr) * N + n0 + c4 * 4);
                tile[kr * 33 + c4 * 4 + 0] = v[0]; tile[kr * 33 + c4 * 4 + 1] = v[1]; tile[kr * 33 + c4 * 4 + 2] = v[2]; tile[kr * 33 + c4 * 4 + 3] = v[3]; }
            __syncthreads();
            { const int n = tid >> 4, k8 = tid & 15; float f[8];
#pragma unroll
              for (int q = 0; q < 8; ++q) f[q] = tile[(k8 * 8 + q) * 33 + n];
              int nd = n0 + n; if (remap) nd = remap_in(nd);
              u32x4 o; o.x = cvt_pk_bf16(f[0], f[1]); o.y = cvt_pk_bf16(f[2], f[3]); o.z = cvt_pk_bf16(f[4], f[5]); o.w = cvt_pk_bf16(f[6], f[7]);
              *(u32x4*)(dst + (size_t)nd * K + k0 + k8 * 8) = o; }
            __syncthreads();
        }
    }
}

__device__ __forceinline__ void phase2(PP p, const int tid) {
    const int wid = tid >> 6, lane = tid & 63;
    const int gw = blockIdx.x * 8 + wid, nw = gridDim.x * 8;
    const bf16_t* proj = (const bf16_t*)(p->ws + WS_PROJ);
    bf16_t* XS = (bf16_t*)(p->ws + WS_R2); bf16_t* XT = (bf16_t*)(p->ws + WS_R3);
    bf16_t* BN = (bf16_t*)(p->ws + WS_BN); bf16_t* CN = (bf16_t*)(p->ws + WS_CN); bf16_t* BT = (bf16_t*)(p->ws + WS_BT);
    const float* cw = p->in[9]; const float* cb = p->in[10];
    for (int it = gw; it < 4 * 264 * 48; it += nw) {
        const int cblk = it % 48, r = it / 48, tau8 = r % 264, b = r / 264;
        const int ch = cblk * 64 + lane;
        const int tp0 = tau8 * 8 - 48;
        float ov[8];
        if (tp0 < 0) {
#pragma unroll
            for (int j = 0; j < 8; ++j) ov[j] = 0.f;
        } else {
            float pre[11];
#pragma unroll
            for (int k = 0; k < 11; ++k) { const int tp = tp0 - 3 + k; pre[k] = tp >= 0 ? bf2f(proj[(size_t)prow(b, tp) * NPROJ + C_XBC + ch]) : 0.f; }
            const float w0 = cw[ch], w1 = cw[3072 + ch], w2 = cw[6144 + ch], w3 = cw[9216 + ch], bias = cb[ch];
#pragma unroll
            for (int j = 0; j < 8; ++j) ov[j] = siluf_(bias + w0 * pre[j] + w1 * pre[j + 1] + w2 * pre[j + 2] + w3 * pre[j + 3]);
#pragma unroll
            for (int j = 0; j < 8; ++j) {
                const int row = prow(b, tp0 + j); const bf16_t o = f2bf(ov[j]);
                if (ch < 2048) XS[(size_t)row * 2048 + ch] = o;
                else if (ch < 2560) BN[(size_t)row * 512 + ch - 2048] = o;
                else CN[(size_t)row * 512 + ch - 2560] = o;
            }
        }
        const int c = tau8 >> 3, l0 = (tau8 & 7) * 8;
        u32x4 o; o.x = cvt_pk_bf16(ov[0], ov[1]); o.y = cvt_pk_bf16(ov[2], ov[3]); o.z = cvt_pk_bf16(ov[4], ov[5]); o.w = cvt_pk_bf16(ov[6], ov[7]);
        if (ch < 2048) { const int h = ch >> 6, pp = ch & 63; *(u32x4*)(XT + ((((size_t)(b * 33 + c) * 32 + h) * 64 + pp) * 64 + l0)) = o; }
        else if (ch < 2560) { const int g = (ch - 2048) >> 7, n = (ch - 2048) & 127; *(u32x4*)(BT + ((((size_t)(b * 33 + c) * 4 + g) * 128 + n) * 64 + l0)) = o; }
    }
    const float* sc = p->in[3];
    for (int it = gw; it < 128 * 48; it += nw) {
        const int cblk = it % 48, bs = it / 48, ch = cblk * 64 + lane, row = 8192 + bs;
        const float p0 = sc[(size_t)(bs * 3 + 0) * 3072 + ch], p1 = sc[(size_t)(bs * 3 + 1) * 3072 + ch], p2 = sc[(size_t)(bs * 3 + 2) * 3072 + ch];
        const float uu = bf2f(proj[(size_t)row * NPROJ + C_XBC + ch]);
        const float v = siluf_(cb[ch] + cw[ch] * p0 + cw[3072 + ch] * p1 + cw[6144 + ch] * p2 + cw[9216 + ch] * uu);
        const bf16_t o = f2bf(v);
        if (ch < 2048) XS[(size_t)row * 2048 + ch] = o;
        else if (ch < 2560) BN[(size_t)row * 512 + ch - 2048] = o;
        else CN[(size_t)row * 512 + ch - 2560] = o;
        float* oc = p->out + O_CONVS + (size_t)bs * 3 * 3072 + ch;
        oc[0] = p1; oc[3072] = p2; oc[6144] = uu;
    }
    const int gt = blockIdx.x * 512 + tid, ntt = gridDim.x * 512;
    for (int i = gt; i < 4 * 3 * 3072; i += ntt) {
        const int ch = i % 3072, k = (i / 3072) % 3, b = i / 9216;
        p->out[O_CONVP + i] = bf2f(proj[(size_t)prow(b, 2061 + k) * NPROJ + C_XBC + ch]);
    }
    float* DT = (float*)(p->ws + WS_DT); const float* dtb = p->in[11];
    for (int i = gt; i < 8336 * 32; i += ntt) DT[i] = softplusf_(DT[i] + dtb[i & 31]);
}

#define MFMA16(a, b, c) __builtin_amdgcn_mfma_f32_16x16x32_bf16((a), (b), (c), 0, 0, 0)

__device__ __forceinline__ void ssd_prompt_unit(PP p, LAS unsigned char* lds, int b, int h, const int tid) {
    const int wid = tid >> 6, lane = tid & 63, fr = lane & 15, fq = lane >> 4, g = h >> 3;
    LAS bf16_t* Cs = (LAS bf16_t*)(lds);
    LAS bf16_t* Bs = (LAS bf16_t*)(lds + 17408);
    LAS bf16_t* BTs = (LAS bf16_t*)(lds + 34816);
    LAS bf16_t* XTs = (LAS bf16_t*)(lds + 53248);
    LAS bf16_t* XTw = (LAS bf16_t*)(lds + 62464);
    LAS bf16_t* Ms = (LAS bf16_t*)(lds + 71680);
    LAS bf16_t* Hs = (LAS bf16_t*)(lds + 80896);
    LAS float* sm = (LAS float*)(lds + 98304);
    const bf16_t* proj = (const bf16_t*)(p->ws + WS_PROJ);
    const bf16_t* XT = (const bf16_t*)(p->ws + WS_R3); const bf16_t* BT = (const bf16_t*)(p->ws + WS_BT);
    const bf16_t* BN = (const bf16_t*)(p->ws + WS_BN); const bf16_t* CN = (const bf16_t*)(p->ws + WS_CN);
    const float* DT = (const float*)(p->ws + WS_DT);
    bf16_t* Y = (bf16_t*)(p->ws + WS_R1); float* GSQ = (float*)(p->ws + WS_GSQ);
    const float Ah = -expf(p->in[12][h]), Dh = p->in[13][h];
    for (int i = tid; i < 64 * 136 / 2; i += 512) ((LAS unsigned*)Hs)[i] = 0u;
    f32x4 Hacc[4];
#pragma unroll
    for (int t = 0; t < 4; ++t) Hacc[t] = (f32x4){0.f, 0.f, 0.f, 0.f};
    const int tr = wid >> 1, tb2 = (wid & 1) * 2, tb4 = (wid & 1) * 4;
    for (int c = 0; c < 33; ++c) {
        const int rl = (c == 0) ? (lane >= 48 ? 8320 + lane - 48 : -1) : b * 2048 + (c - 1) * 64 + lane;
        const float dtv = rl >= 0 ? DT[(size_t)rl * 32 + h] : 0.f;
        float ac = dtv * Ah;
#pragma unroll
        for (int o = 1; o < 64; o <<= 1) { const float t = __shfl_up(ac, o); if (lane >= o) ac += t; }
        const float aend = __shfl(ac, 63);
        const float cdecay = __expf(aend);
        if (wid == 0) { sm[lane] = dtv; sm[64 + lane] = ac; sm[128 + lane] = dtv * __expf(aend - ac); sm[192 + lane] = __expf(ac); }
        u32x4 gc[2], gb[2], gbt[2], gx;
#pragma unroll
        for (int i = 0; i < 2; ++i) {
            const int e = tid + i * 512, row = e >> 4, v = e & 15;
            const int rg = (c == 0) ? (row >= 48 ? 8320 + row - 48 : -1) : b * 2048 + (c - 1) * 64 + row;
            if (rg >= 0) { gc[i] = *(const u32x4*)(CN + (size_t)rg * 512 + g * 128 + v * 8); gb[i] = *(const u32x4*)(BN + (size_t)rg * 512 + g * 128 + v * 8); }
            else { gc[i] = (u32x4){0u, 0u, 0u, 0u}; gb[i] = (u32x4){0u, 0u, 0u, 0u}; }
            gbt[i] = *(const u32x4*)(BT + (((size_t)(b * 33 + c) * 4 + g) * 128) * 64 + (size_t)e * 8);
        }
        gx = *(const u32x4*)(XT + ((((size_t)(b * 33 + c) * 32 + h) * 64) * 64) + (size_t)tid * 8);
        __syncthreads();
#pragma unroll
        for (int i = 0; i < 2; ++i) {
            const int e = tid + i * 512;
            { const int row = e >> 4, v = e & 15; *(LAS u32x4*)(Cs + row * 136 + v * 8) = gc[i]; *(LAS u32x4*)(Bs + row * 136 + v * 8) = gb[i]; }
            { const int n = e >> 3, v = e & 7; *(LAS u32x4*)(BTs + n * 72 + v * 8) = gbt[i]; }
        }
        { const int pp = tid >> 3, v = tid & 7; *(LAS u32x4*)(XTs + pp * 72 + v * 8) = gx;
          const LAS float* wl = sm + 128 + v * 8; u32x4 xw;
          xw.x = cvt_pk_bf16(lo_bf(gx.x) * wl[0], hi_bf(gx.x) * wl[1]); xw.y = cvt_pk_bf16(lo_bf(gx.y) * wl[2], hi_bf(gx.y) * wl[3]);
          xw.z = cvt_pk_bf16(lo_bf(gx.z) * wl[4], hi_bf(gx.z) * wl[5]); xw.w = cvt_pk_bf16(lo_bf(gx.w) * wl[6], hi_bf(gx.w) * wl[7]);
          *(LAS u32x4*)(XTw + pp * 72 + v * 8) = xw; }
        __syncthreads();
        {
            f32x4 cbm[2] = {(f32x4){0.f, 0.f, 0.f, 0.f}, (f32x4){0.f, 0.f, 0.f, 0.f}};
#pragma unroll
            for (int ks = 0; ks < 4; ++ks) {
                const bf16x8 a = *(const LAS bf16x8*)(Cs + (16 * tr + fr) * 136 + ks * 32 + fq * 8);
#pragma unroll
                for (int t = 0; t < 2; ++t) { const bf16x8 bb = *(const LAS bf16x8*)(Bs + (16 * (tb2 + t) + fr) * 136 + ks * 32 + fq * 8); cbm[t] = MFMA16(a, bb, cbm[t]); }
            }
#pragma unroll
            for (int t = 0; t < 2; ++t) {
                const int s = 16 * (tb2 + t) + fr; const float as = sm[64 + s], ds = sm[s];
#pragma unroll
                for (int i = 0; i < 4; ++i) { const int l = 16 * tr + 4 * fq + i; const float al = sm[64 + l];
                    const float v = (s <= l) ? cbm[t][i] * __expf(al - as) * ds : 0.f; Ms[l * 72 + s] = f2bf(v); }
            }
        }
        __syncthreads();
        {
            f32x4 y[2] = {(f32x4){0.f, 0.f, 0.f, 0.f}, (f32x4){0.f, 0.f, 0.f, 0.f}};
#pragma unroll
            for (int ks = 0; ks < 4; ++ks) {
                const bf16x8 a = *(const LAS bf16x8*)(Cs + (16 * tr + fr) * 136 + ks * 32 + fq * 8);
#pragma unroll
                for (int t = 0; t < 2; ++t) { const bf16x8 bb = *(const LAS bf16x8*)(Hs + (16 * (tb2 + t) + fr) * 136 + ks * 32 + fq * 8); y[t] = MFMA16(a, bb, y[t]); }
            }
#pragma unroll
            for (int i = 0; i < 4; ++i) { const float e = sm[192 + 16 * tr + 4 * fq + i]; y[0][i] *= e; y[1][i] *= e; }
#pragma unroll
            for (int ks = 0; ks < 2; ++ks) {
                const bf16x8 a = *(const LAS bf16x8*)(Ms + (16 * tr + fr) * 72 + ks * 32 + fq * 8);
#pragma unroll
                for (int t = 0; t < 2; ++t) { const bf16x8 bb = *(const LAS bf16x8*)(XTs + (16 * (tb2 + t) + fr) * 72 + ks * 32 + fq * 8); y[t] = MFMA16(a, bb, y[t]); }
            }
            float sq[4] = {0.f, 0.f, 0.f, 0.f};
#pragma unroll
            for (int i = 0; i < 4; ++i) {
                const int l = 16 * tr + 4 * fq + i;
                const int rg = (c == 0) ? (l >= 48 ? 8320 + l - 48 : -1) : b * 2048 + (c - 1) * 64 + l;
                if (rg >= 0) {
#pragma unroll
                    for (int t = 0; t < 2; ++t) {
                        const int pc = 16 * (tb2 + t) + fr;
                        const float x = bf2f(XTs[pc * 72 + l]);
                        const float z = bf2f(proj[(size_t)rg * NPROJ + C_ZA + 64 * h + pc]);
                        const float v = (y[t][i] + Dh * x) * z;
                        Y[(size_t)rg * 2048 + 64 * h + pc] = f2bf(v);
                        sq[i] += v * v;
                    }
                }
                float s = sq[i];
                s += __shfl_xor(s, 1); s += __shfl_xor(s, 2); s += __shfl_xor(s, 4); s += __shfl_xor(s, 8);
                if (rg >= 0 && fr == 0) atomicAdd(GSQ + (size_t)rg * 4 + g, s);
            }
        }
        {
#pragma unroll
            for (int t = 0; t < 4; ++t) Hacc[t] *= cdecay;
#pragma unroll
            for (int ks = 0; ks < 2; ++ks) {
                const bf16x8 a = *(const LAS bf16x8*)(XTw + (16 * tr + fr) * 72 + ks * 32 + fq * 8);
#pragma unroll
                for (int t = 0; t < 4; ++t) { const bf16x8 bb = *(const LAS bf16x8*)(BTs + (16 * (tb4 + t) + fr) * 72 + ks * 32 + fq * 8); Hacc[t] = MFMA16(a, bb, Hacc[t]); }
            }
        }
        __syncthreads();
#pragma unroll
        for (int t = 0; t < 4; ++t)
#pragma unroll
            for (int i = 0; i < 4; ++i) Hs[(16 * tr + 4 * fq + i) * 136 + 16 * (tb4 + t) + fr] = f2bf(Hacc[t][i]);
    }
    float* so = p->out + O_SSDP + ((size_t)(b * 32 + h) * 64) * 128;
#pragma unroll
    for (int t = 0; t < 4; ++t)
#pragma unroll
        for (int i = 0; i < 4; ++i) so[(size_t)(16 * tr + 4 * fq + i) * 128 + 16 * (tb4 + t) + fr] = Hacc[t][i];
    __syncthreads();
}

__device__ __forceinline__ void s5_unit(PP p, LAS unsigned char* lds, int b, int g, const int tid) {
    const int wid = tid >> 6, lane = tid & 63, fr = lane & 15, fq = lane >> 4;
    LAS float* coef = (LAS float*)lds;
    LAS float* table = (LAS float*)(lds + 2048);
    LAS float* wbuf = (LAS float*)(lds + 2048 + 66048 + wid * 8448);
    LAS bf16_t* wbh = (LAS bf16_t*)wbuf;
    const bf16_t* proj = (const bf16_t*)(p->ws + WS_PROJ);
    bf16_t* YB = (bf16_t*)(p->ws + WS_YB);
    const bool sample = (b == 4);
    if (wid == 0) {
        const int n = lane;
        const double step = d_exp((double)p->in[18][g]);
        const double lr = (double)p->in[16][g * 64 + n], li = (double)p->in[17][g * 64 + n];
        const double mag = d_exp(lr * step); double sn, cs; d_sincos(li * step, sn, cs);
        const double ar = mag * cs, ai = mag * sn;
        const double den = lr * lr + li * li, nr = ar - 1.0;
        const double cr = (nr * lr + ai * li) / den, ci = (ai * lr - nr * li) / den;
        double pr = ar, pi = ai;
#pragma unroll
        for (int q = 0; q < 4; ++q) { const double t = pr * pr - pi * pi; pi = 2.0 * pr * pi; pr = t; }
        coef[n * 8 + 0] = (float)ar; coef[n * 8 + 1] = (float)ai; coef[n * 8 + 2] = (float)cr; coef[n * 8 + 3] = (float)ci; coef[n * 8 + 4] = (float)pr; coef[n * 8 + 5] = (float)pi;
    }
    __syncthreads();
    bf16x8 Bf[8];
    {
        const float* bre = p->in[19]; const float* bim = p->in[20];
#pragma unroll
        for (int t8 = 0; t8 < 8; ++t8) {
            const int n = (16 * t8 + fr) & 63; const float cr = coef[n * 8 + 2], ci = coef[n * 8 + 3];
            u32x4 w = (u32x4){0u, 0u, 0u, 0u};
            if (fq < 2) {
                const f32x4 r0 = *(const f32x4*)(bre + (size_t)(g * 64 + n) * 16 + 8 * fq), r1 = *(const f32x4*)(bre + (size_t)(g * 64 + n) * 16 + 8 * fq + 4);
                const f32x4 i0 = *(const f32x4*)(bim + (size_t)(g * 64 + n) * 16 + 8 * fq), i1 = *(const f32x4*)(bim + (size_t)(g * 64 + n) * 16 + 8 * fq + 4);
                f32x4 v0, v1;
                if (t8 < 4) { v0 = cr * r0 - ci * i0; v1 = cr * r1 - ci * i1; } else { v0 = cr * i0 + ci * r0; v1 = cr * i1 + ci * r1; }
                w.x = cvt_pk_bf16(v0[0], v0[1]); w.y = cvt_pk_bf16(v0[2], v0[3]); w.z = cvt_pk_bf16(v1[0], v1[1]); w.w = cvt_pk_bf16(v1[2], v1[3]);
            }
            Bf[t8] = __builtin_bit_cast(bf16x8, w);
        }
    }
    bf16x8 Cf[4];
    {
        const float* cre = p->in[21]; const float* cim = p->in[22];
#pragma unroll
        for (int ks = 0; ks < 4; ++ks) {
            const float* src = (ks < 2 ? cre : cim) + (size_t)(g * 16 + fr) * 64 + 32 * (ks & 1) + 8 * fq;
            f32x4 v0 = *(const f32x4*)src, v1 = *(const f32x4*)(src + 4);
            if (ks >= 2) { v0 = -v0; v1 = -v1; }
            u32x4 w; w.x = cvt_pk_bf16(v0[0], v0[1]); w.y = cvt_pk_bf16(v0[2], v0[3]); w.z = cvt_pk_bf16(v1[0], v1[1]); w.w = cvt_pk_bf16(v1[2], v1[3]);
            Cf[ks] = __builtin_bit_cast(bf16x8, w);
        }
    }
    const float a_re = coef[lane * 8 + 0], a_im = coef[lane * 8 + 1];
    const float dsk = p->in[23][16 * g + fr];
    auto row_of = [&](int c, int t) -> int { return sample ? (8192 + 16 * c + t) : (c == 0 ? 8320 + t : b * 2048 + 16 * (c - 1) + t); };
    auto bu_tile = [&](int c) {
        u32x4 a = (u32x4){0u, 0u, 0u, 0u};
        if (fq < 2) a = *(const u32x4*)(proj + (size_t)row_of(c, fr) * NPROJ + C_UB + 16 * g + 8 * fq);
        const bf16x8 af = __builtin_bit_cast(bf16x8, a);
#pragma unroll
        for (int t8 = 0; t8 < 8; ++t8) {
            const f32x4 r = MFMA16(af, Bf[t8], ((f32x4){0.f, 0.f, 0.f, 0.f}));
#pragma unroll
            for (int i = 0; i < 4; ++i) wbuf[(4 * fq + i) * 132 + 16 * t8 + fr] = r[i];
        }
    };
    if (!sample) {
        for (int c = wid; c < 129; c += 8) {
            bu_tile(c);
            float hr = 0.f, hi = 0.f;
#pragma unroll
            for (int t = 0; t < 16; ++t) { const float ur = wbuf[t * 132 + lane], ui = wbuf[t * 132 + 64 + lane];
                const float nr = a_re * hr - a_im * hi + ur; hi = a_re * hi + a_im * hr + ui; hr = nr; }
            table[c * 128 + lane] = hr; table[c * 128 + 64 + lane] = hi;
        }
        __syncthreads();
        if (wid == 0) {
            const float q_re = coef[lane * 8 + 4], q_im = coef[lane * 8 + 5];
            float hr = 0.f, hi = 0.f;
            for (int c = 0; c < 129; ++c) {
                const float lr = table[c * 128 + lane], li = table[c * 128 + 64 + lane];
                table[c * 128 + lane] = hr; table[c * 128 + 64 + lane] = hi;
                const float nr = q_re * hr - q_im * hi + lr; hi = q_re * hi + q_im * hr + li; hr = nr;
            }
            p->out[O_S5RP + (size_t)(b * 64 + g) * 64 + lane] = hr;
            p->out[O_S5IP + (size_t)(b * 64 + g) * 64 + lane] = hi;
        }
        __syncthreads();
    }
    const int cend = sample ? 8 : 129;
    for (int c = wid; c < cend; c += 8) {
        bu_tile(c);
        if (!sample) {
            float hr = table[c * 128 + lane], hi = table[c * 128 + 64 + lane];
#pragma unroll
            for (int t = 0; t < 16; ++t) { const float ur = wbuf[t * 132 + lane], ui = wbuf[t * 132 + 64 + lane];
                const float nr = a_re * hr - a_im * hi + ur; hi = a_re * hi + a_im * hr + ui; hr = nr;
                wbh[t * 264 + lane] = f2bf(hr); wbh[t * 264 + 64 + lane] = f2bf(hi); }
        } else {
            const float* s_re = p->in[4]; const float* s_im = p->in[5];
#pragma unroll
            for (int t = 0; t < 16; ++t) { const int bs = 16 * c + t; const size_t si = (size_t)(bs * 64 + g) * 64 + lane;
                const float h0r = s_re[si], h0i = s_im[si];
                const float ur = wbuf[t * 132 + lane], ui = wbuf[t * 132 + 64 + lane];
                const float hr = a_re * h0r - a_im * h0i + ur, hi = a_re * h0i + a_im * h0r + ui;
                p->out[O_S5RS + si] = hr; p->out[O_S5IS + si] = hi;
                wbh[t * 264 + lane] = f2bf(hr); wbh[t * 264 + 64 + lane] = f2bf(hi); }
        }
        f32x4 y = (f32x4){0.f, 0.f, 0.f, 0.f};
#pragma unroll
        for (int ks = 0; ks < 4; ++ks) { const bf16x8 af = *(const LAS bf16x8*)(wbh + fr * 264 + 32 * ks + 8 * fq); y = MFMA16(af, Cf[ks], y); }
#pragma unroll
        for (int i = 0; i < 4; ++i) {
            const int row = row_of(c, 4 * fq + i);
            const float uu = bf2f(proj[(size_t)row * NPROJ + C_UB + 16 * g + fr]);
            YB[(size_t)row * 1024 + 16 * g + fr] = f2bf(gelu_tanh(y[i] + dsk * uu));
        }
    }
    __syncthreads();
}

__device__ __forceinline__ void ssd_sample_unit(PP p, LAS unsigned char* lds, int bs, int g, const int tid) {
    const int n4 = tid & 31, row = 8192 + bs;
    LAS float* ybuf = (LAS float*)lds;
    LAS float* red = ybuf + 512;
    const bf16_t* proj = (const bf16_t*)(p->ws + WS_PROJ);
    const bf16_t* XS = (const bf16_t*)(p->ws + WS_R2);
    const bf16_t* BN = (const bf16_t*)(p->ws + WS_BN); const bf16_t* CN = (const bf16_t*)(p->ws + WS_CN);
    const float* DT = (const float*)(p->ws + WS_DT);
    bf16_t* Y = (bf16_t*)(p->ws + WS_R1); float* GSQ = (float*)(p->ws + WS_GSQ);
    const u32x2 bw = *(const u32x2*)(BN + (size_t)row * 512 + g * 128 + 4 * n4), cw = *(const u32x2*)(CN + (size_t)row * 512 + g * 128 + 4 * n4);
    const f32x4 Bv = (f32x4){lo_bf(bw.x), hi_bf(bw.x), lo_bf(bw.y), hi_bf(bw.y)}, Cv = (f32x4){lo_bf(cw.x), hi_bf(cw.x), lo_bf(cw.y), hi_bf(cw.y)};
    for (int hh = 0; hh < 8; ++hh) {
        const int h = 8 * g + hh;
        const float dt = DT[(size_t)row * 32 + h], dA = __expf(-dt * expf(p->in[12][h])), Dh = p->in[13][h];
        const float* s0 = p->in[2] + ((size_t)(bs * 32 + h) * 64) * 128;
        float* s1 = p->out + O_SSDS + ((size_t)(bs * 32 + h) * 64) * 128;
#pragma unroll
        for (int k = 0; k < 4; ++k) {
            const int pp = (tid >> 5) + 16 * k;
            const float x = bf2f(XS[(size_t)row * 2048 + 64 * h + pp]), dtx = dt * x;
            const f32x4 h0 = *(const f32x4*)(s0 + (size_t)pp * 128 + 4 * n4);
            const f32x4 hn = dA * h0 + dtx * Bv;
            *(f32x4*)(s1 + (size_t)pp * 128 + 4 * n4) = hn;
            float part = Cv[0] * hn[0] + Cv[1] * hn[1] + Cv[2] * hn[2] + Cv[3] * hn[3];
            part += __shfl_xor(part, 1); part += __shfl_xor(part, 2); part += __shfl_xor(part, 4); part += __shfl_xor(part, 8); part += __shfl_xor(part, 16);
            if (n4 == 0) { const float z = bf2f(proj[(size_t)row * NPROJ + C_ZA + 64 * h + pp]); ybuf[hh * 64 + pp] = (part + Dh * x) * z; }
        }
    }
    __syncthreads();
    const float v = ybuf[tid];
    Y[(size_t)row * 2048 + 512 * g + tid] = f2bf(v);
    float s = v * v;
#pragma unroll
    for (int o = 32; o >= 1; o >>= 1) s += __shfl_xor(s, o);
    if ((tid & 63) == 0) red[tid >> 6] = s;
    __syncthreads();
    if (tid == 0) { float t = 0.f; for (int i = 0; i < 8; ++i) t += red[i]; GSQ[(size_t)row * 4 + g] = t; }
    __syncthreads();
}

__device__ __forceinline__ void phase3(PP p, LAS unsigned char* lds) {
    LAS int* qslot = (LAS int*)(lds + LDS_BYTES - 16);
    unsigned* ctr = (unsigned*)(p->ws + WS_CTL);
    for (;;) {
        __syncthreads();
        if (threadIdx.x == 0) *qslot = (int)atomicAdd(ctr, 1u);
        __syncthreads();
        const int it = __builtin_amdgcn_readfirstlane(*qslot);
        if (it >= 960) break;
        int tid = threadIdx.x; asm volatile("" : "+v"(tid));
        if (it < 128) ssd_prompt_unit(p, lds, it >> 5, it & 31, tid);
        else if (it < 384) s5_unit(p, lds, (it - 128) >> 6, (it - 128) & 63, tid);
        else if (it < 448) s5_unit(p, lds, 4, it - 384, tid);
        else ssd_sample_unit(p, lds, (it - 448) >> 2, (it - 448) & 3, tid);
    }
}

__device__ __forceinline__ void ynorm_fix(PP p, LAS unsigned char* lds, const int tid) {
    const int wid = tid >> 6, lane = tid & 63;
    LAS int* qslot = (LAS int*)(lds + LDS_BYTES - 16);
    unsigned* ctr = (unsigned*)(p->ws + WS_CTL) + 1;
    bf16_t* Y = (bf16_t*)(p->ws + WS_R1); const float* GSQ = (const float*)(p->ws + WS_GSQ); const float* nw = p->in[14];
    for (;;) {
        __syncthreads();
        if (tid == 0) *qslot = (int)atomicAdd(ctr, 1u);
        __syncthreads();
        const int it = *qslot;
        if (it >= 1040) break;
        const int r = it * 8 + wid;
#pragma unroll
        for (int i = 0; i < 4; ++i) {
            const float rs = rsqrtf(GSQ[(size_t)r * 4 + i] * (1.0f / 512.0f) + 1e-5f);
            u32x4* ptr = (u32x4*)(Y + (size_t)r * 2048) + i * 64 + lane;
            const u32x4 v = *ptr;
            const f32x4 w0 = *(const f32x4*)(nw + (i * 64 + lane) * 8), w1 = *(const f32x4*)(nw + (i * 64 + lane) * 8 + 4);
            u32x4 o;
            o.x = cvt_pk_bf16(lo_bf(v.x) * rs * w0[0], hi_bf(v.x) * rs * w0[1]); o.y = cvt_pk_bf16(lo_bf(v.y) * rs * w0[2], hi_bf(v.y) * rs * w0[3]);
            o.z = cvt_pk_bf16(lo_bf(v.z) * rs * w1[0], hi_bf(v.z) * rs * w1[1]); o.w = cvt_pk_bf16(lo_bf(v.w) * rs * w1[2], hi_bf(v.w) * rs * w1[3]);
            *ptr = o;
        }
    }
}

__device__ __forceinline__ void phase7(PP p, const int tid) {
    const int wid = tid >> 6, lane = tid & 63;
    const float* rowsq = (const float*)(p->ws + WS_ROWSQ); const float* fw = p->in[28];
    for (int r = blockIdx.x * 8 + wid; r < 8320; r += gridDim.x * 8) {
        const float rs = rsqrtf(rowsq[r] * (1.0f / 2048.0f) + 1e-5f);
        f32x4* ptr = (f32x4*)(p->out + (size_t)r * 2048);
#pragma unroll
        for (int i = 0; i < 8; ++i) { const f32x4 w = ((const f32x4*)fw)[i * 64 + lane]; f32x4 v = ptr[i * 64 + lane]; v = v * rs * w; ptr[i * 64 + lane] = v; }
    }
}

__global__ void __launch_bounds__(512) mk_fwd(Params pa, int ph_lo, int ph_hi) {
    extern __shared__ __attribute__((aligned(16))) unsigned char smem[];
    LAS unsigned char* lds = (LAS unsigned char*)smem;
    cg::grid_group grid = cg::this_grid();
#define PH_BEGIN(k) if (ph_lo <= (k) && (k) < ph_hi) { if (ph_lo < (k)) grid.sync(); \
        PP p = (PP)__builtin_amdgcn_kernarg_segment_ptr(); asm volatile("" : "+s"(p)); int tid = threadIdx.x; asm volatile("" : "+v"(tid)); \
        const bf16_t* PROJ = (const bf16_t*)(p->ws + WS_PROJ); (void)PROJ;
#define PH_END }
    PH_BEGIN(0) phase0(p, lds, tid); PH_END
    PH_BEGIN(1)
        pg8::Gemm g{(const bf16_t*)(p->ws + WS_R1), (const bf16_t*)(p->ws + WS_WTIN), MP, NPROJ, 2048};
        pg8::StaticOrder S; S.init(MP, NPROJ, gridDim.x, blockIdx.x);
        EpiProj E{(bf16_t*)(p->ws + WS_PROJ), (float*)(p->ws + WS_DT)};
        pg8::gemm_phase(lds, g, S, E, tid);
    PH_END
    PH_BEGIN(2) phase2(p, tid); PH_END
    PH_BEGIN(3) phase3(p, lds); PH_END
    PH_BEGIN(4)
        pg8::Gemm g{(const bf16_t*)(p->ws + WS_YB), (const bf16_t*)(p->ws + WS_WTGLU), MP, 1024, 1024};
        pg8::StaticOrder S; S.init(MP, 1024, gridDim.x, blockIdx.x);
        EpiGlu E{(const bf16_t*)(p->ws + WS_YB), PROJ, p->in[25], (bf16_t*)(p->ws + WS_YB2)};
        pg8::gemm_phase(lds, g, S, E, tid);
        ynorm_fix(p, lds, tid);
    PH_END
    PH_BEGIN(5)
        pg8::StaticOrder S; S.init(MP, 2048, gridDim.x, blockIdx.x);
        { pg8::Gemm g{(const bf16_t*)(p->ws + WS_R1), (const bf16_t*)(p->ws + WS_WTA), MP, 2048, 2048};
          EpiMix<0> E{PROJ, nullptr, (bf16_t*)(p->ws + WS_R3)};
          pg8::gemm_phase(lds, g, S, E, tid); }
        { pg8::Gemm g{(const bf16_t*)(p->ws + WS_YB2), (const bf16_t*)(p->ws + WS_WTB), MP, 2048, 1024};
          EpiMix<1> E{PROJ, (const bf16_t*)(p->ws + WS_R3), (bf16_t*)(p->ws + WS_R2)};
          pg8::gemm_phase(lds, g, S, E, tid); }
    PH_END
    PH_BEGIN(6)
        pg8::Gemm g{(const bf16_t*)(p->ws + WS_R2), (const bf16_t*)(p->ws + WS_WTOUT), MP, 2048, 2048};
        pg8::StaticOrder S; S.init(MP, 2048, gridDim.x, blockIdx.x);
        EpiOut E{p->in[0], p->in[1], p->out, (float*)(p->ws + WS_ROWSQ)};
        pg8::gemm_phase(lds, g, S, E, tid);
    PH_END
    PH_BEGIN(7) phase7(p, tid); PH_END
}

extern "C" void kernel_launch(void* const* d_in, const int* in_sizes, int n_in, void* d_out, int out_size, void* d_ws, size_t ws_size, hipStream_t stream) {
    static int grid_blocks = 0;
    if (grid_blocks == 0) {
        if (n_in != 29 || ws_size < WS_END) { fprintf(stderr, "kernel_launch: unexpected n_in %d or ws_size %zu (< %zu)\n", n_in, ws_size, (size_t)WS_END); grid_blocks = -1; return; }
        int dev = 0, cus = 0, per_cu = 0;
        hipGetDevice(&dev);
        hipDeviceGetAttribute(&cus, hipDeviceAttributeMultiprocessorCount, dev);
        if (hipFuncSetAttribute((const void*)mk_fwd, hipFuncAttributeMaxDynamicSharedMemorySize, LDS_BYTES) != hipSuccess) { fprintf(stderr, "kernel_launch: hipFuncSetAttribute failed\n"); grid_blocks = -1; return; }
        if (hipOccupancyMaxActiveBlocksPerMultiprocessor(&per_cu, (const void*)mk_fwd, 512, LDS_BYTES) != hipSuccess || per_cu < 1) { fprintf(stderr, "kernel_launch: occupancy query gave %d\n", per_cu); per_cu = 1; (void)hipGetLastError(); }
        grid_blocks = cus * per_cu;
    }
    if (grid_blocks < 0) return;
    Params p{};
    for (int i = 0; i < 29; ++i) p.in[i] = (const float*)d_in[i];
    p.out = (float*)d_out; p.ws = (unsigned char*)d_ws;
#if ONE_LAUNCH
    int lo = 0, hi = 8;
    void* args[] = {&p, &lo, &hi};
    hipError_t e = hipLaunchCooperativeKernel((const void*)mk_fwd, dim3(grid_blocks), dim3(512), args, LDS_BYTES, stream);
    if (e != hipSuccess) fprintf(stderr, "cooperative launch failed: %s (grid %d)\n", hipGetErrorString(e), grid_blocks);
#else
    for (int ph = 0; ph < 8; ++ph) hipLaunchKernelGGL(mk_fwd, dim3(grid_blocks), dim3(512), LDS_BYTES, stream, p, ph, ph + 1);
#endif
}
```

```cpp
#include <hip/hip_runtime.h>
#include <hip/hip_cooperative_groups.h>
#include <cstdio>
namespace cg = cooperative_groups;

#define DUP_PH -1
#define DUP_LO 0
#define DUP_HI 128
#ifndef ONE_LAUNCH
#define ONE_LAUNCH 1
#endif

#define LAS __attribute__((address_space(3)))
typedef unsigned short bf16_t;
typedef short bf16x8 __attribute__((ext_vector_type(8)));
typedef float f32x4 __attribute__((ext_vector_type(4)));
typedef float f32x2 __attribute__((ext_vector_type(2)));
typedef unsigned u32x4 __attribute__((ext_vector_type(4)));
typedef unsigned u32x2 __attribute__((ext_vector_type(2)));

constexpr int MP = 8448;
constexpr int NPROJ = 11520;
constexpr int C_ZA = 0, C_XBC = 2048, C_UB = 5120, C_ZB = 6144, C_GA = 7168, C_GB = 9216, C_DT = 11264;
constexpr int LDS_BYTES = 139264;

constexpr size_t O_YP = 0, O_YS = 16777216, O_SSDP = 17039360, O_CONVP = 18087936, O_S5RP = 18124800, O_S5IP = 18141184,
                 O_SSDS = 18157568, O_CONVS = 51712000, O_S5RS = 52891648, O_S5IS = 53415936;

constexpr size_t WS_CTL = 0;
constexpr size_t WS_ROWSQ = 4096;
constexpr size_t WS_GSQ = WS_ROWSQ + (size_t)MP * 32 * 4;
constexpr size_t WS_DT = WS_GSQ + (size_t)MP * 32 * 4;
constexpr size_t WS_WTIN = WS_DT + 1081344;
constexpr size_t WS_WTA = WS_WTIN + (size_t)NPROJ * 2048 * 2;
constexpr size_t WS_WTGLU = WS_WTA + (size_t)2048 * 2048 * 2;
constexpr size_t WS_WTB = WS_WTGLU + (size_t)1024 * 1024 * 2;
constexpr size_t WS_WTOUT = WS_WTB + (size_t)2048 * 1024 * 2;
constexpr size_t WS_R1 = WS_WTOUT + (size_t)2048 * 2048 * 2;
constexpr size_t WS_R2 = WS_R1 + (size_t)MP * 2048 * 2;
constexpr size_t WS_R3 = WS_R2 + (size_t)MP * 2048 * 2;
constexpr size_t WS_PROJ = WS_R3 + (size_t)MP * 2048 * 2;
constexpr size_t WS_BN = WS_PROJ + (size_t)MP * NPROJ * 2;
constexpr size_t WS_CN = WS_BN + (size_t)MP * 512 * 2;
constexpr size_t WS_BT = WS_CN + (size_t)MP * 512 * 2;
constexpr size_t WS_YB = WS_BT + (size_t)MP * 512 * 2;
constexpr size_t WS_YB2 = WS_YB + (size_t)MP * 1024 * 2;
constexpr size_t WS_END = WS_YB2 + (size_t)MP * 1024 * 2;

struct Params {
    const float* in[29];
    float* out;
    unsigned char* ws;
};
typedef const __attribute__((address_space(4))) Params* PP;

__device__ __forceinline__ float bf2f(bf16_t b) { return __uint_as_float(((unsigned)b) << 16); }
__device__ __forceinline__ bf16_t f2bf(float f) { unsigned u = __float_as_uint(f); u += 0x7FFFu + ((u >> 16) & 1u); return (bf16_t)(u >> 16); }
__device__ __forceinline__ unsigned cvt_pk_bf16(float lo, float hi) { unsigned r; asm volatile("v_cvt_pk_bf16_f32 %0, %1, %2" : "=v"(r) : "v"(lo), "v"(hi)); return r; }
__device__ __forceinline__ float lo_bf(unsigned w) { return __uint_as_float(w << 16); }
__device__ __forceinline__ float hi_bf(unsigned w) { return __uint_as_float(w & 0xffff0000u); }
__device__ __forceinline__ float sigmoidf_(float x) { return __builtin_amdgcn_rcpf(1.0f + __expf(-x)); }
__device__ __forceinline__ float siluf_(float x) { return x * sigmoidf_(x); }
__device__ __forceinline__ float gelu_tanh(float x) {
    const float u = 0.7978845608028654f * (x + 0.044715f * x * x * x);
    const float e = __expf(2.0f * u);
    const float t = 1.0f - 2.0f * __builtin_amdgcn_rcpf(1.0f + e);
    return 0.5f * x * (1.0f + t);
}
__device__ __forceinline__ float softplusf_(float x) { return fmaxf(x, 0.0f) + log1pf(__expf(-fabsf(x))); }
__device__ __forceinline__ int prow(int b, int tp) { return tp < 16 ? (8320 + tp) : (b * 2048 + tp - 16); }

__device__ __forceinline__ float red16_dpp(float v) {
    v += __int_as_float(__builtin_amdgcn_update_dpp(0, __float_as_int(v), 0xB1, 0xF, 0xF, true));
    v += __int_as_float(__builtin_amdgcn_update_dpp(0, __float_as_int(v), 0x4E, 0xF, 0xF, true));
    v += __int_as_float(__builtin_amdgcn_update_dpp(0, __float_as_int(v), 0x141, 0xF, 0xF, true));
    v += __int_as_float(__builtin_amdgcn_update_dpp(0, __float_as_int(v), 0x140, 0xF, 0xF, true));
    return v;
}

__device__ __forceinline__ double d_exp(double x) {
    const double kf = __builtin_rint(x * 1.4426950408889634);
    const double r = (x - kf * 0.693147180369123816490e+00) - kf * 1.90821492927058770002e-10;
    double s = 1.0 / 6227020800.0;
    s = s * r + 1.0 / 479001600.0;
    s = s * r + 1.0 / 39916800.0;
    s = s * r + 1.0 / 3628800.0;
    s = s * r + 1.0 / 362880.0;
    s = s * r + 1.0 / 40320.0;
    s = s * r + 1.0 / 5040.0;
    s = s * r + 1.0 / 720.0;
    s = s * r + 1.0 / 120.0;
    s = s * r + 1.0 / 24.0;
    s = s * r + 1.0 / 6.0;
    s = s * r + 0.5;
    s = s * r + 1.0;
    s = s * r + 1.0;
    const long long bits = ((long long)((int)kf + 1023)) << 52;
    return s * __longlong_as_double(bits);
}
__device__ __forceinline__ void d_sincos(double x, double& sn, double& cs) {
    const double kf = __builtin_rint(x * 0.63661977236758134308);
    const double y = (x - kf * 1.57079632673412561417e+00) - kf * 6.07710050650619224932e-11;
    const double y2 = y * y;
    double ps = -1.0 / 1307674368000.0;
    ps = ps * y2 + 1.0 / 6227020800.0;
    ps = ps * y2 - 1.0 / 39916800.0;
    ps = ps * y2 + 1.0 / 362880.0;
    ps = ps * y2 - 1.0 / 5040.0;
    ps = ps * y2 + 1.0 / 120.0;
    ps = ps * y2 - 1.0 / 6.0;
    ps = ps * y2 + 1.0;
    const double s0 = y * ps;
    double pc = 1.0 / 20922789888000.0;
    pc = pc * y2 - 1.0 / 87178291200.0;
    pc = pc * y2 + 1.0 / 479001600.0;
    pc = pc * y2 - 1.0 / 3628800.0;
    pc = pc * y2 + 1.0 / 40320.0;
    pc = pc * y2 - 1.0 / 720.0;
    pc = pc * y2 + 1.0 / 24.0;
    pc = pc * y2 - 0.5;
    pc = pc * y2 + 1.0;
    const int q = ((int)kf) & 3;
    sn = (q == 0) ? s0 : (q == 1) ? pc : (q == 2) ? -s0 : -pc;
    cs = (q == 0) ? pc : (q == 1) ? -s0 : (q == 2) ? -pc : s0;
}

namespace pg8 {
constexpr int BM = 256, BK = 64, HALF = 128, HTB = HALF * BK * 2, STAGE_BYTES = 8 * HTB, NXCD = 8, WGM = 8;
__device__ __forceinline__ int lds_byte(int r, int c) { const int st = (r >> 4) * 2 + (c >> 5), rr = r & 15, cc = c & 31, ob = rr * 64 + cc * 2; return st * 1024 + (ob ^ (((ob >> 9) & 1) << 5)); }
__device__ __forceinline__ void stage_rc(int b, int& R, int& C) { const int st = b / 1024, sb = b % 1024, swz = sb ^ (((sb >> 9) & 1) << 5); R = (st >> 1) * 16 + swz / 64; C = (st & 1) * 32 + (swz % 64) / 2; }
__device__ __forceinline__ int perm32(int rho) { const int n = rho >> 4, i = rho & 15; return 8 * (i >> 2) + 4 * n + (i & 3); }
struct Unit { int pm, pn; };
struct Gemm { const bf16_t* A; const bf16_t* Bt; int M, N, K; };
struct StaticOrder {
    int nM, nN, nwg, G, c;
    __device__ void init(int M, int N, int G_, int c_) { nM = M / BM; nN = N / BM; nwg = nM * nN; G = G_; c = c_; }
    __device__ bool next(int i, Unit& u) const {
        const long L = (long)i * G + c; if (L >= nwg) return false;
        int wgid = (int)L; { const int q = nwg / NXCD, r = nwg % NXCD, xcd = wgid % NXCD, off = wgid / NXCD; wgid = (xcd < r ? xcd * (q + 1) : r * (q + 1) + (xcd - r) * q) + off; }
        const int nig = WGM * nN, gid = wgid / nig, fm = gid * WGM, gsz = (nM - fm) < WGM ? (nM - fm) : WGM;
        u.pm = fm + ((wgid % nig) % gsz); u.pn = (wgid % nig) / gsz; return true;
    }
};
template <class Epi, class Sched>
__device__ __forceinline__ void gemm_phase(LAS unsigned char* lds, const Gemm g, const Sched& S, const Epi& E, const int tid) {
    const int wid = __builtin_amdgcn_readfirstlane(tid >> 6), lane = tid & 63, wr = wid >> 2, wc = wid & 3, fr = lane & 15, fq = lane >> 4;
    const int K = g.K, nt = K / BK;
    unsigned voffA[2], voffB[2];
#pragma unroll
    for (int i = 0; i < 2; ++i) { int R, C; stage_rc(tid * 16 + i * 8192, R, C); const int Rb = Epi::PERM ? ((R & ~31) + perm32(R & 31)) : R;
        voffA[i] = (unsigned)(R * K + C) * 2u; voffB[i] = (unsigned)(Rb * K + C) * 2u; }
    const size_t kstep = (size_t)(BK * 2);
    const size_t hstep = (size_t)HALF * K * 2;
    const size_t tstep = 2 * hstep;
    const unsigned ldsw = (unsigned)wid * 1024u;
    const int aoff = lds_byte(wr * 64 + fr, fq * 8), boff = lds_byte(wc * 32 + fr, fq * 8);
#define PG8_SA(b, h) (((b) * 2 + (h)) * HTB)
#define PG8_SB(b, h) ((4 + (b) * 2 + (h)) * HTB)
#define PG8_STAGE(bufoff, gbase, voff) do { _Pragma("unroll") for (int _i = 0; _i < 2; ++_i) \
        __builtin_amdgcn_global_load_lds((const unsigned*)((const char*)(gbase) + (voff)[_i]), (LAS unsigned*)(lds + (bufoff) + ldsw + _i * 8192), 16, 0, 0); } while (0)
#define PG8_LDA(dst, b, h) do { _Pragma("unroll") for (int m = 0; m < 4; ++m) _Pragma("unroll") for (int k = 0; k < 2; ++k) dst[m][k] = *(const LAS bf16x8*)(lds + PG8_SA(b, h) + aoff + m * 2048 + k * 1024); } while (0)
#define PG8_LDB(dst, b, h) do { _Pragma("unroll") for (int n = 0; n < 2; ++n) _Pragma("unroll") for (int k = 0; k < 2; ++k) dst[n][k] = *(const LAS bf16x8*)(lds + PG8_SB(b, h) + boff + n * 2048 + k * 1024); } while (0)
#define PG8_MMA(ai, bj, At, Bt) do { __builtin_amdgcn_s_setprio(1); _Pragma("unroll") for (int m = 0; m < 4; ++m) _Pragma("unroll") for (int n = 0; n < 2; ++n) _Pragma("unroll") for (int k = 0; k < 2; ++k) \
        acc[ai][bj][m][n] = __builtin_amdgcn_mfma_f32_16x16x32_bf16(Bt[n][k], At[m][k], acc[ai][bj][m][n], 0, 0, 0); __builtin_amdgcn_s_setprio(0); } while (0)
#define PG8_WAIT_V(n) asm volatile("s_waitcnt vmcnt(" #n ")" ::: "memory")
#define PG8_WAIT_L(n) asm volatile("s_waitcnt lgkmcnt(" #n ")" ::: "memory")
#define PG8_BAR __builtin_amdgcn_s_barrier()
#define PG8_SCHED __builtin_amdgcn_sched_barrier(0)
    Unit cur, nxt; int ui = 0;
    if (!S.next(0, cur)) return;
    f32x4 acc[2][2][4][2];
#pragma unroll
    for (int a = 0; a < 2; ++a)
#pragma unroll
        for (int b = 0; b < 2; ++b)
#pragma unroll
            for (int m = 0; m < 4; ++m)
#pragma unroll
                for (int n = 0; n < 2; ++n) acc[a][b][m][n] = (f32x4){0.f, 0.f, 0.f, 0.f};
    bf16x8 At[4][2], B0[2][2], B1[2][2];
    const char* cA = (const char*)g.A + (size_t)cur.pm * tstep; const char* cB = (const char*)g.Bt + (size_t)cur.pn * tstep;
    PG8_STAGE(PG8_SB(0, 0), cB, voffB); PG8_STAGE(PG8_SA(0, 0), cA, voffA); PG8_STAGE(PG8_SB(0, 1), cB + hstep, voffB); PG8_STAGE(PG8_SA(0, 1), cA + hstep, voffA);
    if (wr == 1) PG8_BAR;
    PG8_WAIT_V(4); PG8_BAR;
    PG8_STAGE(PG8_SB(1, 0), cB + kstep, voffB); PG8_STAGE(PG8_SA(1, 0), cA + kstep, voffA); PG8_STAGE(PG8_SB(1, 1), cB + hstep + kstep, voffB);
    PG8_WAIT_V(6); PG8_BAR;
    for (;;) {
        const bool has_next = S.next(ui + 1, nxt);
        const char* nA = has_next ? (const char*)g.A + (size_t)nxt.pm * tstep : cA; const char* nB = has_next ? (const char*)g.Bt + (size_t)nxt.pn * tstep : cB;
        for (int t = 0; t < nt; t += 2) {
            const bool last = (t == nt - 2);
            const char* a1 = cA + (size_t)(t + 1) * kstep;
            const char* a2 = last ? nA : cA + (size_t)(t + 2) * kstep; const char* b2 = last ? nB : cB + (size_t)(t + 2) * kstep;
            const char* a3 = a2 + kstep; const char* b3 = b2 + kstep;
            PG8_LDB(B0, 0, 0); PG8_SCHED; PG8_LDA(At, 0, 0); PG8_STAGE(PG8_SA(1, 1), a1 + hstep, voffA);
            PG8_WAIT_L(8); PG8_BAR; PG8_WAIT_L(0); PG8_MMA(0, 0, At, B0); PG8_BAR; PG8_SCHED;
            PG8_LDB(B1, 0, 1); PG8_STAGE(PG8_SB(0, 0), b2, voffB);
            PG8_BAR; PG8_WAIT_L(0); PG8_MMA(0, 1, At, B1); PG8_BAR;
            PG8_LDA(At, 0, 1); PG8_STAGE(PG8_SA(0, 0), a2, voffA);
            PG8_BAR; PG8_WAIT_L(0); PG8_MMA(1, 0, At, B0); PG8_BAR; PG8_SCHED;
            PG8_STAGE(PG8_SB(0, 1), b2 + hstep, voffB);
            PG8_WAIT_V(6); PG8_BAR; PG8_MMA(1, 1, At, B1); PG8_BAR;
            PG8_LDB(B0, 1, 0); PG8_SCHED; PG8_LDA(At, 1, 0); PG8_STAGE(PG8_SA(0, 1), a2 + hstep, voffA);
            PG8_WAIT_L(8); PG8_BAR; PG8_WAIT_L(0); PG8_MMA(0, 0, At, B0); PG8_BAR; PG8_SCHED;
            PG8_LDB(B1, 1, 1); PG8_STAGE(PG8_SB(1, 0), b3, voffB);
            PG8_BAR; PG8_WAIT_L(0); PG8_MMA(0, 1, At, B1); PG8_BAR;
            PG8_LDA(At, 1, 1); PG8_STAGE(PG8_SA(1, 0), a3, voffA);
            PG8_BAR; PG8_WAIT_L(0); PG8_MMA(1, 0, At, B0); PG8_BAR; PG8_SCHED;
            PG8_STAGE(PG8_SB(1, 1), b3 + hstep, voffB);
            PG8_WAIT_V(6); PG8_BAR; PG8_MMA(1, 1, At, B1); PG8_BAR;
        }
        E(acc, cur, wr, wc, fr, fq);
        if (!has_next) break;
#pragma unroll
        for (int a = 0; a < 2; ++a)
#pragma unroll
            for (int b = 0; b < 2; ++b)
#pragma unroll
                for (int m = 0; m < 4; ++m)
#pragma unroll
                    for (int n = 0; n < 2; ++n) acc[a][b][m][n] = (f32x4){0.f, 0.f, 0.f, 0.f};
        cur = nxt; cA = nA; cB = nB; ++ui;
    }
    PG8_WAIT_V(0);
    if (wr == 0) PG8_BAR;
    PG8_BAR;
#undef PG8_SA
#undef PG8_SB
#undef PG8_STAGE
#undef PG8_LDA
#undef PG8_LDB
#undef PG8_MMA
#undef PG8_WAIT_V
#undef PG8_WAIT_L
#undef PG8_BAR
#undef PG8_SCHED
}
}
using pg8::Unit;

struct EpiProj {
    static constexpr bool PERM = true;
    bf16_t* O; float* DT;
    __device__ __forceinline__ void operator()(const f32x4 (&acc)[2][2][4][2], const Unit& u, int wr, int wc, int fr, int fq) const {
        const int row0 = u.pm * 256 + wr * 64 + fr, col0 = u.pn * 256 + wc * 32 + 8 * fq;
        const int act = (u.pn < 8 || (u.pn >= 24 && u.pn < 28)) ? 1 : ((u.pn >= 28 && u.pn < 44) ? 2 : 0);
#pragma unroll
        for (int ai = 0; ai < 2; ++ai)
#pragma unroll
            for (int m = 0; m < 4; ++m) {
                const int row = row0 + ai * 128 + m * 16;
                bf16_t* rowp = O + (size_t)row * NPROJ + col0;
#pragma unroll
                for (int bj = 0; bj < 2; ++bj) {
                    f32x4 v0 = acc[ai][bj][m][0], v1 = acc[ai][bj][m][1];
                    if (u.pn == 44 && bj == 0 && wc == 0) { float* d = DT + (size_t)row * 32 + 8 * fq; *(f32x4*)d = v0; *(f32x4*)(d + 4) = v1; }
                    if (act == 1) {
#pragma unroll
                        for (int j = 0; j < 4; ++j) { v0[j] = siluf_(v0[j]); v1[j] = siluf_(v1[j]); }
                    } else if (act == 2) {
#pragma unroll
                        for (int j = 0; j < 4; ++j) { v0[j] = sigmoidf_(v0[j]); v1[j] = sigmoidf_(v1[j]); }
                    }
                    u32x4 w; w.x = cvt_pk_bf16(v0[0], v0[1]); w.y = cvt_pk_bf16(v0[2], v0[3]); w.z = cvt_pk_bf16(v1[0], v1[1]); w.w = cvt_pk_bf16(v1[2], v1[3]);
                    *(u32x4*)(rowp + bj * 128) = w;
                }
            }
    }
};
struct EpiGlu {
    static constexpr bool PERM = true;
    const bf16_t* YB; const bf16_t* PROJ; const float* bias; bf16_t* O;
    __device__ __forceinline__ void operator()(const f32x4 (&acc)[2][2][4][2], const Unit& u, int wr, int wc, int fr, int fq) const {
        const int row0 = u.pm * 256 + wr * 64 + fr, col0 = u.pn * 256 + wc * 32 + 8 * fq;
#pragma unroll
        for (int bj = 0; bj < 2; ++bj) {
            const int col = col0 + bj * 128;
            const f32x4 b0 = *(const f32x4*)(bias + col), b1 = *(const f32x4*)(bias + col + 4);
#pragma unroll
            for (int ai = 0; ai < 2; ++ai)
#pragma unroll
                for (int m = 0; m < 4; ++m) {
                    const int row = row0 + ai * 128 + m * 16;
                    const u32x4 yb = *(const u32x4*)(YB + (size_t)row * 1024 + col);
                    const u32x4 zb = *(const u32x4*)(PROJ + (size_t)row * NPROJ + C_ZB + col);
                    const f32x4 v0 = acc[ai][bj][m][0] + b0, v1 = acc[ai][bj][m][1] + b1;
                    u32x4 w;
                    w.x = cvt_pk_bf16(lo_bf(yb.x) * sigmoidf_(v0[0]) * lo_bf(zb.x), hi_bf(yb.x) * sigmoidf_(v0[1]) * hi_bf(zb.x));
                    w.y = cvt_pk_bf16(lo_bf(yb.y) * sigmoidf_(v0[2]) * lo_bf(zb.y), hi_bf(yb.y) * sigmoidf_(v0[3]) * hi_bf(zb.y));
                    w.z = cvt_pk_bf16(lo_bf(yb.z) * sigmoidf_(v1[0]) * lo_bf(zb.z), hi_bf(yb.z) * sigmoidf_(v1[1]) * hi_bf(zb.z));
                    w.w = cvt_pk_bf16(lo_bf(yb.w) * sigmoidf_(v1[2]) * lo_bf(zb.w), hi_bf(yb.w) * sigmoidf_(v1[3]) * hi_bf(zb.w));
                    *(u32x4*)(O + (size_t)row * 1024 + col) = w;
                    asm volatile("" ::: "memory");
                }
        }
    }
};
template <int SECOND> struct EpiMix {
    static constexpr bool PERM = true;
    const bf16_t* PROJ; const bf16_t* PREV; bf16_t* O;
    __device__ __forceinline__ void operator()(const f32x4 (&acc)[2][2][4][2], const Unit& u, int wr, int wc, int fr, int fq) const {
        const int row0 = u.pm * 256 + wr * 64 + fr, col0 = u.pn * 256 + wc * 32 + 8 * fq;
#pragma unroll
        for (int ai = 0; ai < 2; ++ai)
#pragma unroll
            for (int m = 0; m < 4; ++m) {
                const int row = row0 + ai * 128 + m * 16;
#pragma unroll
                for (int bj = 0; bj < 2; ++bj) {
                    const int col = col0 + bj * 128;
                    const u32x4 gt = *(const u32x4*)(PROJ + (size_t)row * NPROJ + (SECOND ? C_GB : C_GA) + col);
                    const f32x4 v0 = acc[ai][bj][m][0], v1 = acc[ai][bj][m][1];
                    float o[8] = {lo_bf(gt.x) * v0[0], hi_bf(gt.x) * v0[1], lo_bf(gt.y) * v0[2], hi_bf(gt.y) * v0[3],
                                  lo_bf(gt.z) * v1[0], hi_bf(gt.z) * v1[1], lo_bf(gt.w) * v1[2], hi_bf(gt.w) * v1[3]};
                    if (SECOND) {
                        const u32x4 pv = *(const u32x4*)(PREV + (size_t)row * 2048 + col);
                        o[0] += lo_bf(pv.x); o[1] += hi_bf(pv.x); o[2] += lo_bf(pv.y); o[3] += hi_bf(pv.y);
                        o[4] += lo_bf(pv.z); o[5] += hi_bf(pv.z); o[6] += lo_bf(pv.w); o[7] += hi_bf(pv.w);
                    }
                    u32x4 w; w.x = cvt_pk_bf16(o[0], o[1]); w.y = cvt_pk_bf16(o[2], o[3]); w.z = cvt_pk_bf16(o[4], o[5]); w.w = cvt_pk_bf16(o[6], o[7]);
                    *(u32x4*)(O + (size_t)row * 2048 + col) = w;
                    asm volatile("" ::: "memory");
                }
            }
    }
};
struct EpiOut {
    static constexpr bool PERM = false;
    const float* xp; const float* xs; float* out; float* rowsq;
    __device__ __forceinline__ void operator()(const f32x4 (&acc)[2][2][4][2], const Unit& u, int wr, int wc, int fr, int fq) const {
        const int row0 = u.pm * 256 + wr * 64 + fr, col0 = u.pn * 256 + wc * 32 + 4 * fq;
#pragma unroll
        for (int ai = 0; ai < 2; ++ai)
#pragma unroll
            for (int m = 0; m < 4; ++m) {
                const int row = row0 + ai * 128 + m * 16;
                const bool ok = row < 8320;
                const float* hp = row < 8192 ? xp + (size_t)row * 2048 : xs + (size_t)(ok ? row - 8192 : 0) * 2048;
                float s = 0.f;
                if (ok) {
#pragma unroll
                    for (int bj = 0; bj < 2; ++bj)
#pragma unroll
                        for (int n = 0; n < 2; ++n) {
                            const int col = col0 + bj * 128 + n * 16;
                            const f32x4 o = *(const f32x4*)(hp + col) + acc[ai][bj][m][n];
                            *(f32x4*)(out + (size_t)row * 2048 + col) = o;
                            s += o[0] * o[0] + o[1] * o[1] + o[2] * o[2] + o[3] * o[3];
                        }
                }
                s += __shfl_xor(s, 16); s += __shfl_xor(s, 32);
                if (ok && fq == 0) rowsq[(size_t)row * 32 + u.pn * 4 + wc] = s;
            }
    }
};

__device__ __forceinline__ int remap_in(int n) { return n < 5120 ? n : (n < 5152 ? C_DT + (n - 5120) : n - 32); }
__device__ __forceinline__ void phase0(PP p, LAS unsigned char* lds, const int tid) {
    const int bid = blockIdx.x, nb = gridDim.x, wid = tid >> 6, lane = tid & 63;
    {
        unsigned* ctl = (unsigned*)(p->ws + WS_CTL);
        if (bid == 0 && tid < 64) ctl[tid] = 0u;
    }
    {
        bf16_t* xn = (bf16_t*)(p->ws + WS_R1); const float* nw = p->in[7];
        for (int r = bid * 8 + wid; r < MP; r += nb * 8) {
            const float* src = nullptr;
            if (r < 8192) src = p->in[0] + (size_t)r * 2048;
            else if (r < 8320) src = p->in[1] + (size_t)(r - 8192) * 2048;
            else if (r < 8336) src = p->in[6] + (size_t)(r - 8320) * 2048;
            u32x2* dst = (u32x2*)(xn + (size_t)r * 2048);
            if (!src) {
#pragma unroll
                for (int i = 0; i < 8; ++i) dst[i * 64 + lane] = (u32x2){0u, 0u};
                continue;
            }
            f32x4 v[8]; float ss = 0.f;
#pragma unroll
            for (int i = 0; i < 8; ++i) { v[i] = ((const f32x4*)src)[i * 64 + lane]; ss += v[i][0] * v[i][0] + v[i][1] * v[i][1] + v[i][2] * v[i][2] + v[i][3] * v[i][3]; }
#pragma unroll
            for (int o = 32; o >= 1; o >>= 1) ss += __shfl_xor(ss, o);
            const float rs = rsqrtf(ss * (1.0f / 2048.0f) + 1e-5f);
#pragma unroll
            for (int i = 0; i < 8; ++i) { const f32x4 w = ((const f32x4*)nw)[i * 64 + lane]; u32x2 o; o.x = cvt_pk_bf16(v[i][0] * rs * w[0], v[i][1] * rs * w[1]); o.y = cvt_pk_bf16(v[i][2] * rs * w[2], v[i][3] * rs * w[3]); dst[i * 64 + lane] = o; }
        }
    }
    {
        LAS float* tile = (LAS float*)lds;
#define WT_DECODE(job_, src_, dst_, N_, K_, n0_, k0_, remap_) do { int j_ = (job_); int nt_, kt_; remap_ = false; \
            if (j_ < 5648) { src_ = p->in[8]; dst_ = (bf16_t*)(p->ws + WS_WTIN); N_ = 11296; K_ = 2048; nt_ = j_ >> 4; kt_ = j_ & 15; remap_ = true; } \
            else if ((j_ -= 5648) < 1024) { src_ = p->in[15]; dst_ = (bf16_t*)(p->ws + WS_WTA); N_ = 2048; K_ = 2048; nt_ = j_ >> 4; kt_ = j_ & 15; } \
            else if ((j_ -= 1024) < 256) { src_ = p->in[24]; dst_ = (bf16_t*)(p->ws + WS_WTGLU); N_ = 1024; K_ = 1024; nt_ = j_ >> 3; kt_ = j_ & 7; } \
            else if ((j_ -= 256) < 512) { src_ = p->in[26]; dst_ = (bf16_t*)(p->ws + WS_WTB); N_ = 2048; K_ = 1024; nt_ = j_ >> 3; kt_ = j_ & 7; } \
            else { j_ -= 512; src_ = p->in[27]; dst_ = (bf16_t*)(p->ws + WS_WTOUT); N_ = 2048; K_ = 2048; nt_ = j_ >> 4; kt_ = j_ & 15; } \
            n0_ = nt_ * 32; k0_ = kt_ * 128; } while (0)
        const int kr0 = tid >> 3, c4 = tid & 7;
        int job = bid;
        const float* src; bf16_t* dst; int N, K, n0, k0; bool remap;
        f32x4 v0 = (f32x4){0.f, 0.f, 0.f, 0.f}, v1 = v0;
        if (job < 8464) { WT_DECODE(job, src, dst, N, K, n0, k0, remap);
            v0 = *(const f32x4*)(src + (size_t)(k0 + kr0) * N + n0 + c4 * 4); v1 = *(const f32x4*)(src + (size_t)(k0 + kr0 + 64) * N + n0 + c4 * 4); }
        while (job < 8464) {
            tile[kr0 * 33 + c4 * 4 + 0] = v0[0]; tile[kr0 * 33 + c4 * 4 + 1] = v0[1]; tile[kr0 * 33 + c4 * 4 + 2] = v0[2]; tile[kr0 * 33 + c4 * 4 + 3] = v0[3];
            tile[(kr0 + 64) * 33 + c4 * 4 + 0] = v1[0]; tile[(kr0 + 64) * 33 + c4 * 4 + 1] = v1[1]; tile[(kr0 + 64) * 33 + c4 * 4 + 2] = v1[2]; tile[(kr0 + 64) * 33 + c4 * 4 + 3] = v1[3];
            bf16_t* cdst = dst; const int cK = K, cn0 = n0, ck0 = k0; const bool cremap = remap;
            job += nb;
            if (job < 8464) { WT_DECODE(job, src, dst, N, K, n0, k0, remap);
                v0 = *(const f32x4*)(src + (size_t)(k0 + kr0) * N + n0 + c4 * 4); v1 = *(const f32x4*)(src + (size_t)(k0 + kr0 + 64) * N + n0 + c4 * 4); }
            __syncthreads();
            { const int n = tid >> 4, k8 = tid & 15; float f[8];
#pragma unroll
              for (int q = 0; q < 8; ++q) f[q] = tile[(k8 * 8 + q) * 33 + n];
              int nd = cn0 + n; if (cremap) nd = remap_in(nd);
              u32x4 o; o.x = cvt_pk_bf16(f[0], f[1]); o.y = cvt_pk_bf16(f[2], f[3]); o.z = cvt_pk_bf16(f[4], f[5]); o.w = cvt_pk_bf16(f[6], f[7]);
              *(u32x4*)(cdst + (size_t)nd * cK + ck0 + k8 * 8) = o; }
            __syncthreads();
        }
#undef WT_DECODE
    }
}

__device__ __forceinline__ void phase2(PP p, const int tid) {
    const int wid = tid >> 6, lane = tid & 63;
    const int gw = blockIdx.x * 8 + wid, nw = gridDim.x * 8;
    const bf16_t* proj = (const bf16_t*)(p->ws + WS_PROJ);
    bf16_t* XS = (bf16_t*)(p->ws + WS_R2); bf16_t* XT = (bf16_t*)(p->ws + WS_R3);
    bf16_t* BN = (bf16_t*)(p->ws + WS_BN); bf16_t* CN = (bf16_t*)(p->ws + WS_CN); bf16_t* BT = (bf16_t*)(p->ws + WS_BT);
    const float* cw = p->in[9]; const float* cb = p->in[10];
#define CONV_LOAD(it_, dstv_) do { const int cblk_ = (it_) % 48, r_ = (it_) / 48, tau8_ = r_ % 264, b_ = r_ / 264; const int ch_ = cblk_ * 64 + lane, tp0_ = tau8_ * 8 - 48; \
        _Pragma("unroll") for (int k_ = 0; k_ < 11; ++k_) { const int tp_ = tp0_ - 3 + k_; dstv_[k_] = (tp0_ >= 0 && tp_ >= 0) ? proj[(size_t)prow(b_, tp_) * NPROJ + C_XBC + ch_] : (bf16_t)0; } } while (0)
    {
        bf16_t cur[11], nxt[11];
#pragma unroll
        for (int k = 0; k < 11; ++k) { cur[k] = 0; nxt[k] = 0; }
        if (gw < 4 * 264 * 48) CONV_LOAD(gw, cur);
        for (int it = gw; it < 4 * 264 * 48; it += nw) {
            if (it + nw < 4 * 264 * 48) CONV_LOAD(it + nw, nxt);
            const int cblk = it % 48, r = it / 48, tau8 = r % 264, b = r / 264;
            const int ch = cblk * 64 + lane;
            const int tp0 = tau8 * 8 - 48;
            float ov[8];
            if (tp0 < 0) {
#pragma unroll
                for (int j = 0; j < 8; ++j) ov[j] = 0.f;
            } else {
                float pre[11];
#pragma unroll
                for (int k = 0; k < 11; ++k) pre[k] = bf2f(cur[k]);
                const float w0 = cw[ch], w1 = cw[3072 + ch], w2 = cw[6144 + ch], w3 = cw[9216 + ch], bias = cb[ch];
#pragma unroll
                for (int j = 0; j < 8; ++j) ov[j] = siluf_(bias + w0 * pre[j] + w1 * pre[j + 1] + w2 * pre[j + 2] + w3 * pre[j + 3]);
#pragma unroll
                for (int j = 0; j < 8; ++j) {
                    const int row = prow(b, tp0 + j); const bf16_t o = f2bf(ov[j]);
                    if (ch < 2048) XS[(size_t)row * 2048 + ch] = o;
                    else if (ch < 2560) BN[(size_t)row * 512 + ch - 2048] = o;
                    else CN[(size_t)row * 512 + ch - 2560] = o;
                }
            }
            const int c = tau8 >> 3, l0 = (tau8 & 7) * 8;
            u32x4 o; o.x = cvt_pk_bf16(ov[0], ov[1]); o.y = cvt_pk_bf16(ov[2], ov[3]); o.z = cvt_pk_bf16(ov[4], ov[5]); o.w = cvt_pk_bf16(ov[6], ov[7]);
            if (ch < 2048) { const int h = ch >> 6, pp = ch & 63; *(u32x4*)(XT + ((((size_t)(b * 33 + c) * 32 + h) * 64 + pp) * 64 + l0)) = o; }
            else if (ch < 2560) { const int g = (ch - 2048) >> 7, n = (ch - 2048) & 127; *(u32x4*)(BT + ((((size_t)(b * 33 + c) * 4 + g) * 128 + n) * 64 + l0)) = o; }
#pragma unroll
            for (int k = 0; k < 11; ++k) cur[k] = nxt[k];
        }
    }
#undef CONV_LOAD
    const float* sc = p->in[3];
    for (int it = gw; it < 128 * 48; it += nw) {
        const int cblk = it % 48, bs = it / 48, ch = cblk * 64 + lane, row = 8192 + bs;
        const float p0 = sc[(size_t)(bs * 3 + 0) * 3072 + ch], p1 = sc[(size_t)(bs * 3 + 1) * 3072 + ch], p2 = sc[(size_t)(bs * 3 + 2) * 3072 + ch];
        const float uu = bf2f(proj[(size_t)row * NPROJ + C_XBC + ch]);
        const float v = siluf_(cb[ch] + cw[ch] * p0 + cw[3072 + ch] * p1 + cw[6144 + ch] * p2 + cw[9216 + ch] * uu);
        const bf16_t o = f2bf(v);
        if (ch < 2048) XS[(size_t)row * 2048 + ch] = o;
        else if (ch < 2560) BN[(size_t)row * 512 + ch - 2048] = o;
        else CN[(size_t)row * 512 + ch - 2560] = o;
        float* oc = p->out + O_CONVS + (size_t)bs * 3 * 3072 + ch;
        oc[0] = p1; oc[3072] = p2; oc[6144] = uu;
    }
    const int gt = blockIdx.x * 512 + tid, ntt = gridDim.x * 512;
    for (int i = gt; i < 4 * 3 * 3072; i += ntt) {
        const int ch = i % 3072, k = (i / 3072) % 3, b = i / 9216;
        p->out[O_CONVP + i] = bf2f(proj[(size_t)prow(b, 2061 + k) * NPROJ + C_XBC + ch]);
    }
    float* DT = (float*)(p->ws + WS_DT); const float* dtb = p->in[11];
    for (int i = gt; i < 8336 * 32; i += ntt) DT[i] = softplusf_(DT[i] + dtb[i & 31]);
}

#define MFMA16(a, b, c) __builtin_amdgcn_mfma_f32_16x16x32_bf16((a), (b), (c), 0, 0, 0)

__device__ __forceinline__ void ssd_prompt_unit(PP p, LAS unsigned char* lds, int b, int h, const int tid) {
    const int wid = tid >> 6, lane = tid & 63, fr = lane & 15, fq = lane >> 4, g = h >> 3;
    LAS bf16_t* Cs = (LAS bf16_t*)(lds);
    LAS bf16_t* Bs = (LAS bf16_t*)(lds + 17408);
    LAS bf16_t* BTs = (LAS bf16_t*)(lds + 34816);
    LAS bf16_t* XTs = (LAS bf16_t*)(lds + 53248);
    LAS bf16_t* XTw = (LAS bf16_t*)(lds + 62464);
    LAS bf16_t* Ms = (LAS bf16_t*)(lds + 71680);
    LAS bf16_t* Hs = (LAS bf16_t*)(lds + 80896);
    LAS float* sm = (LAS float*)(lds + 98304);
    LAS bf16_t* Zs = (LAS bf16_t*)(lds + 100352);
    LAS bf16_t* Ys = (LAS bf16_t*)(lds + 109568);
    const bf16_t* proj = (const bf16_t*)(p->ws + WS_PROJ);
    const bf16_t* XT = (const bf16_t*)(p->ws + WS_R3); const bf16_t* BT = (const bf16_t*)(p->ws + WS_BT);
    const bf16_t* BN = (const bf16_t*)(p->ws + WS_BN); const bf16_t* CN = (const bf16_t*)(p->ws + WS_CN);
    const float* DT = (const float*)(p->ws + WS_DT);
    bf16_t* Y = (bf16_t*)(p->ws + WS_R1); float* GSQ = (float*)(p->ws + WS_GSQ);
    const float Ah = -expf(p->in[12][h]), Dh = p->in[13][h];
    for (int i = tid; i < 64 * 136 / 2; i += 512) ((LAS unsigned*)Hs)[i] = 0u;
    f32x4 Hacc[4];
#pragma unroll
    for (int t = 0; t < 4; ++t) Hacc[t] = (f32x4){0.f, 0.f, 0.f, 0.f};
    const int tr = wid >> 1, tb2 = (wid & 1) * 2, tb4 = (wid & 1) * 4;
    u32x4 gc[2], gb[2], gbt[2], gx, gz; float gdt;
#define SSD_ROW(c_, l_) ((c_) == 0 ? ((l_) >= 48 ? 8320 + (l_) - 48 : -1) : b * 2048 + ((c_) - 1) * 64 + (l_))
#define SSD_PREFETCH(c_) do { \
        { const int rl_ = SSD_ROW(c_, lane); gdt = rl_ >= 0 ? DT[(size_t)rl_ * 32 + h] : 0.f; } \
        _Pragma("unroll") for (int i_ = 0; i_ < 2; ++i_) { \
            const int e_ = tid + i_ * 512, row_ = e_ >> 4, v_ = e_ & 15; const int rg_ = SSD_ROW(c_, row_); \
            if (rg_ >= 0) { gc[i_] = *(const u32x4*)(CN + (size_t)rg_ * 512 + g * 128 + v_ * 8); gb[i_] = *(const u32x4*)(BN + (size_t)rg_ * 512 + g * 128 + v_ * 8); } \
            else { gc[i_] = (u32x4){0u, 0u, 0u, 0u}; gb[i_] = (u32x4){0u, 0u, 0u, 0u}; } \
            gbt[i_] = *(const u32x4*)(BT + (((size_t)(b * 33 + (c_)) * 4 + g) * 128) * 64 + (size_t)e_ * 8); } \
        gx = *(const u32x4*)(XT + ((((size_t)(b * 33 + (c_)) * 32 + h) * 64) * 64) + (size_t)tid * 8); \
        { const int rg_ = SSD_ROW(c_, tid >> 3); gz = rg_ >= 0 ? *(const u32x4*)(proj + (size_t)rg_ * NPROJ + C_ZA + 64 * h + (tid & 7) * 8) : (u32x4){0u, 0u, 0u, 0u}; } \
    } while (0)
    SSD_PREFETCH(0);
    for (int c = 0; c < 33; ++c) {
        const float dtv = gdt;
        float ac = dtv * Ah;
#pragma unroll
        for (int o = 1; o < 64; o <<= 1) { const float t = __shfl_up(ac, o); if (lane >= o) ac += t; }
        const float aend = __shfl(ac, 63);
        const float cdecay = __expf(aend);
        const float wl = dtv * __expf(aend - ac);
        if (wid == 0) { sm[lane] = dtv; sm[64 + lane] = ac; sm[192 + lane] = __expf(ac); }
#pragma unroll
        for (int i = 0; i < 2; ++i) {
            const int e = tid + i * 512;
            { const int row = e >> 4, v = e & 15; *(LAS u32x4*)(Cs + row * 136 + v * 8) = gc[i]; *(LAS u32x4*)(Bs + row * 136 + v * 8) = gb[i]; }
            { const int n = e >> 3, v = e & 7; *(LAS u32x4*)(BTs + n * 72 + v * 8) = gbt[i]; }
        }
        { const int pp = tid >> 3, v = tid & 7; *(LAS u32x4*)(XTs + pp * 72 + v * 8) = gx; *(LAS u32x4*)(Zs + pp * 72 + v * 8) = gz;
          float w8[8];
#pragma unroll
          for (int j = 0; j < 8; ++j) w8[j] = __shfl(wl, v * 8 + j);
          u32x4 xw;
          xw.x = cvt_pk_bf16(lo_bf(gx.x) * w8[0], hi_bf(gx.x) * w8[1]); xw.y = cvt_pk_bf16(lo_bf(gx.y) * w8[2], hi_bf(gx.y) * w8[3]);
          xw.z = cvt_pk_bf16(lo_bf(gx.z) * w8[4], hi_bf(gx.z) * w8[5]); xw.w = cvt_pk_bf16(lo_bf(gx.w) * w8[6], hi_bf(gx.w) * w8[7]);
          *(LAS u32x4*)(XTw + pp * 72 + v * 8) = xw; }
        if (c + 1 < 33) SSD_PREFETCH(c + 1);
        __syncthreads();
        {
            f32x4 cbm[2] = {(f32x4){0.f, 0.f, 0.f, 0.f}, (f32x4){0.f, 0.f, 0.f, 0.f}};
#pragma unroll
            for (int ks = 0; ks < 4; ++ks) {
                const bf16x8 a = *(const LAS bf16x8*)(Cs + (16 * tr + fr) * 136 + ks * 32 + fq * 8);
#pragma unroll
                for (int t = 0; t < 2; ++t) { const bf16x8 bb = *(const LAS bf16x8*)(Bs + (16 * (tb2 + t) + fr) * 136 + ks * 32 + fq * 8); cbm[t] = MFMA16(a, bb, cbm[t]); }
            }
#pragma unroll
            for (int t = 0; t < 2; ++t) {
                const int s_ = 16 * (tb2 + t) + fr; const float as = sm[64 + s_], ds = sm[s_];
#pragma unroll
                for (int i = 0; i < 4; ++i) { const int l = 16 * tr + 4 * fq + i; const float al = sm[64 + l];
                    const float v = (s_ <= l) ? cbm[t][i] * __expf(al - as) * ds : 0.f; Ms[l * 72 + s_] = f2bf(v); }
            }
        }
        __syncthreads();
        {
            f32x4 y[2] = {(f32x4){0.f, 0.f, 0.f, 0.f}, (f32x4){0.f, 0.f, 0.f, 0.f}};
#pragma unroll
            for (int ks = 0; ks < 4; ++ks) {
                const bf16x8 a = *(const LAS bf16x8*)(Cs + (16 * tr + fr) * 136 + ks * 32 + fq * 8);
#pragma unroll
                for (int t = 0; t < 2; ++t) { const bf16x8 bb = *(const LAS bf16x8*)(Hs + (16 * (tb2 + t) + fr) * 136 + ks * 32 + fq * 8); y[t] = MFMA16(a, bb, y[t]); }
            }
#pragma unroll
            for (int i = 0; i < 4; ++i) { const float e = sm[192 + 16 * tr + 4 * fq + i]; y[0][i] *= e; y[1][i] *= e; }
#pragma unroll
            for (int ks = 0; ks < 2; ++ks) {
                const bf16x8 a = *(const LAS bf16x8*)(Ms + (16 * tr + fr) * 72 + ks * 32 + fq * 8);
#pragma unroll
                for (int t = 0; t < 2; ++t) { const bf16x8 bb = *(const LAS bf16x8*)(XTs + (16 * (tb2 + t) + fr) * 72 + ks * 32 + fq * 8); y[t] = MFMA16(a, bb, y[t]); }
            }
#pragma unroll
            for (int i = 0; i < 4; ++i) {
                const int l = 16 * tr + 4 * fq + i;
                float sq = 0.f;
#pragma unroll
                for (int t = 0; t < 2; ++t) {
                    const int pc = 16 * (tb2 + t) + fr;
                    const float x = bf2f(XTs[pc * 72 + l]);
                    const float z = bf2f(Zs[l * 72 + pc]);
                    const float v = (y[t][i] + Dh * x) * z;
                    Ys[l * 72 + pc] = f2bf(v);
                    sq += v * v;
                }
                sq = red16_dpp(sq);
                if (fr == 0) sm[256 + l * 2 + (wid & 1)] = sq;
            }
        }
        {
#pragma unroll
            for (int t = 0; t < 4; ++t) Hacc[t] *= cdecay;
#pragma unroll
            for (int ks = 0; ks < 2; ++ks) {
                const bf16x8 a = *(const LAS bf16x8*)(XTw + (16 * tr + fr) * 72 + ks * 32 + fq * 8);
#pragma unroll
                for (int t = 0; t < 4; ++t) { const bf16x8 bb = *(const LAS bf16x8*)(BTs + (16 * (tb4 + t) + fr) * 72 + ks * 32 + fq * 8); Hacc[t] = MFMA16(a, bb, Hacc[t]); }
            }
        }
        __syncthreads();
#pragma unroll
        for (int t = 0; t < 4; ++t)
#pragma unroll
            for (int i = 0; i < 4; ++i) Hs[(16 * tr + 4 * fq + i) * 136 + 16 * (tb4 + t) + fr] = f2bf(Hacc[t][i]);
        { const int l = tid >> 3, v = tid & 7; const int rg = SSD_ROW(c, l);
          if (rg >= 0) *(u32x4*)(Y + (size_t)rg * 2048 + 64 * h + v * 8) = *(const LAS u32x4*)(Ys + l * 72 + v * 8);
          if (rg >= 0 && v == 0) GSQ[(size_t)rg * 32 + h] = sm[256 + l * 2] + sm[256 + l * 2 + 1]; }
    }
#undef SSD_PREFETCH
#undef SSD_ROW
    float* so = p->out + O_SSDP + ((size_t)(b * 32 + h) * 64) * 128;
#pragma unroll
    for (int t = 0; t < 4; ++t)
#pragma unroll
        for (int i = 0; i < 4; ++i) so[(size_t)(16 * tr + 4 * fq + i) * 128 + 16 * (tb4 + t) + fr] = Hacc[t][i];
    __syncthreads();
}

__device__ __forceinline__ void s5_unit(PP p, LAS unsigned char* lds, int b, int g, const int tid) {
    const int wid = tid >> 6, lane = tid & 63, fr = lane & 15, fq = lane >> 4;
    LAS float* coef = (LAS float*)lds;
    LAS float* table = (LAS float*)(lds + 2048);
    LAS float* wbuf = (LAS float*)(lds + 2048 + 66048 + wid * 8448);
    LAS bf16_t* wbh = (LAS bf16_t*)wbuf;
    const bf16_t* proj = (const bf16_t*)(p->ws + WS_PROJ);
    bf16_t* YB = (bf16_t*)(p->ws + WS_YB);
    const bool sample = (b == 4);
    if (wid == 0) {
        const int n = lane;
        const double step = d_exp((double)p->in[18][g]);
        const double lr = (double)p->in[16][g * 64 + n], li = (double)p->in[17][g * 64 + n];
        const double mag = d_exp(lr * step); double sn, cs; d_sincos(li * step, sn, cs);
        const double ar = mag * cs, ai = mag * sn;
        const double den = lr * lr + li * li, nr = ar - 1.0;
        const double cr = (nr * lr + ai * li) / den, ci = (ai * lr - nr * li) / den;
        double pr = ar, pi = ai;
#pragma unroll
        for (int q = 0; q < 4; ++q) { const double t = pr * pr - pi * pi; pi = 2.0 * pr * pi; pr = t; }
        coef[n * 8 + 0] = (float)ar; coef[n * 8 + 1] = (float)ai; coef[n * 8 + 2] = (float)cr; coef[n * 8 + 3] = (float)ci; coef[n * 8 + 4] = (float)pr; coef[n * 8 + 5] = (float)pi;
    }
    __syncthreads();
    bf16x8 Bf[8];
    {
        const float* bre = p->in[19]; const float* bim = p->in[20];
#pragma unroll
        for (int t8 = 0; t8 < 8; ++t8) {
            const int n = (16 * t8 + fr) & 63; const float cr = coef[n * 8 + 2], ci = coef[n * 8 + 3];
            u32x4 w = (u32x4){0u, 0u, 0u, 0u};
            if (fq < 2) {
                const f32x4 r0 = *(const f32x4*)(bre + (size_t)(g * 64 + n) * 16 + 8 * fq), r1 = *(const f32x4*)(bre + (size_t)(g * 64 + n) * 16 + 8 * fq + 4);
                const f32x4 i0 = *(const f32x4*)(bim + (size_t)(g * 64 + n) * 16 + 8 * fq), i1 = *(const f32x4*)(bim + (size_t)(g * 64 + n) * 16 + 8 * fq + 4);
                f32x4 v0, v1;
                if (t8 < 4) { v0 = cr * r0 - ci * i0; v1 = cr * r1 - ci * i1; } else { v0 = cr * i0 + ci * r0; v1 = cr * i1 + ci * r1; }
                w.x = cvt_pk_bf16(v0[0], v0[1]); w.y = cvt_pk_bf16(v0[2], v0[3]); w.z = cvt_pk_bf16(v1[0], v1[1]); w.w = cvt_pk_bf16(v1[2], v1[3]);
            }
            Bf[t8] = __builtin_bit_cast(bf16x8, w);
        }
    }
    bf16x8 Cf[4];
    {
        const float* cre = p->in[21]; const float* cim = p->in[22];
#pragma unroll
        for (int ks = 0; ks < 4; ++ks) {
            const float* src = (ks < 2 ? cre : cim) + (size_t)(g * 16 + fr) * 64 + 32 * (ks & 1) + 8 * fq;
            f32x4 v0 = *(const f32x4*)src, v1 = *(const f32x4*)(src + 4);
            if (ks >= 2) { v0 = -v0; v1 = -v1; }
            u32x4 w; w.x = cvt_pk_bf16(v0[0], v0[1]); w.y = cvt_pk_bf16(v0[2], v0[3]); w.z = cvt_pk_bf16(v1[0], v1[1]); w.w = cvt_pk_bf16(v1[2], v1[3]);
            Cf[ks] = __builtin_bit_cast(bf16x8, w);
        }
    }
    const float a_re = coef[lane * 8 + 0], a_im = coef[lane * 8 + 1];
    const float dsk = p->in[23][16 * g + fr];
    auto row_of = [&](int c, int t) -> int { return sample ? (8192 + 16 * c + t) : (c == 0 ? 8320 + t : b * 2048 + 16 * (c - 1) + t); };
    auto load_a = [&](int c) -> u32x4 {
        u32x4 a = (u32x4){0u, 0u, 0u, 0u};
        if (fq < 2) a = *(const u32x4*)(proj + (size_t)row_of(c, fr) * NPROJ + C_UB + 16 * g + 8 * fq);
        return a; };
    auto bu_tile = [&](const u32x4 a) {
        const bf16x8 af = __builtin_bit_cast(bf16x8, a);
#pragma unroll
        for (int t8 = 0; t8 < 8; ++t8) {
            const f32x4 r = MFMA16(af, Bf[t8], ((f32x4){0.f, 0.f, 0.f, 0.f}));
#pragma unroll
            for (int i = 0; i < 4; ++i) wbuf[(4 * fq + i) * 132 + 16 * t8 + fr] = r[i];
        }
    };
    if (!sample) {
        u32x4 a_nxt = load_a(wid);
        for (int c = wid; c < 129; c += 8) {
            const u32x4 a_cur = a_nxt; if (c + 8 < 129) a_nxt = load_a(c + 8);
            bu_tile(a_cur);
            float hr = 0.f, hi = 0.f;
#pragma unroll
            for (int t = 0; t < 16; ++t) { const float ur = wbuf[t * 132 + lane], ui = wbuf[t * 132 + 64 + lane];
                const float nr = a_re * hr - a_im * hi + ur; hi = a_re * hi + a_im * hr + ui; hr = nr; }
            table[c * 128 + lane] = hr; table[c * 128 + 64 + lane] = hi;
        }
        __syncthreads();
        if (wid == 0) {
            const float q_re = coef[lane * 8 + 4], q_im = coef[lane * 8 + 5];
            float hr = 0.f, hi = 0.f;
            for (int c = 0; c < 129; ++c) {
                const float lr = table[c * 128 + lane], li = table[c * 128 + 64 + lane];
                table[c * 128 + lane] = hr; table[c * 128 + 64 + lane] = hi;
                const float nr = q_re * hr - q_im * hi + lr; hi = q_re * hi + q_im * hr + li; hr = nr;
            }
            p->out[O_S5RP + (size_t)(b * 64 + g) * 64 + lane] = hr;
            p->out[O_S5IP + (size_t)(b * 64 + g) * 64 + lane] = hi;
        }
        __syncthreads();
    }
    const int cend = sample ? 8 : 129;
    u32x4 a_nxt2 = load_a(wid);
    for (int c = wid; c < cend; c += 8) {
        const u32x4 a_cur = a_nxt2; if (c + 8 < cend) a_nxt2 = load_a(c + 8);
        bu_tile(a_cur);
        if (!sample) {
            float hr = table[c * 128 + lane], hi = table[c * 128 + 64 + lane];
#pragma unroll
            for (int t = 0; t < 16; ++t) { const float ur = wbuf[t * 132 + lane], ui = wbuf[t * 132 + 64 + lane];
                const float nr = a_re * hr - a_im * hi + ur; hi = a_re * hi + a_im * hr + ui; hr = nr;
                wbh[t * 264 + lane] = f2bf(hr); wbh[t * 264 + 64 + lane] = f2bf(hi); }
        } else {
            const float* s_re = p->in[4]; const float* s_im = p->in[5];
#pragma unroll
            for (int t = 0; t < 16; ++t) { const int bs = 16 * c + t; const size_t si = (size_t)(bs * 64 + g) * 64 + lane;
                const float h0r = s_re[si], h0i = s_im[si];
                const float ur = wbuf[t * 132 + lane], ui = wbuf[t * 132 + 64 + lane];
                const float hr = a_re * h0r - a_im * h0i + ur, hi = a_re * h0i + a_im * h0r + ui;
                p->out[O_S5RS + si] = hr; p->out[O_S5IS + si] = hi;
                wbh[t * 264 + lane] = f2bf(hr); wbh[t * 264 + 64 + lane] = f2bf(hi); }
        }
        if (fq < 2) *(LAS u32x4*)(wbh + fr * 264 + 128 + 8 * fq) = a_cur;
        f32x4 y = (f32x4){0.f, 0.f, 0.f, 0.f};
#pragma unroll
        for (int ks = 0; ks < 4; ++ks) { const bf16x8 af = *(const LAS bf16x8*)(wbh + fr * 264 + 32 * ks + 8 * fq); y = MFMA16(af, Cf[ks], y); }
#pragma unroll
        for (int i = 0; i < 4; ++i) {
            const int row = row_of(c, 4 * fq + i);
            const float uu = bf2f(wbh[(4 * fq + i) * 264 + 128 + fr]);
            YB[(size_t)row * 1024 + 16 * g + fr] = f2bf(gelu_tanh(y[i] + dsk * uu));
        }
    }
    __syncthreads();
}

__device__ __forceinline__ void ssd_sample_unit(PP p, LAS unsigned char* lds, int bs, int g, const int tid) {
    const int n4 = tid & 31, row = 8192 + bs, p0 = tid >> 5;
    LAS float* ybuf = (LAS float*)lds;
    LAS float* red = ybuf + 512;
    LAS float* xsf = ybuf + 544;
    LAS float* zsf = ybuf + 1056;
    LAS float* hsc = ybuf + 1568;
    const bf16_t* proj = (const bf16_t*)(p->ws + WS_PROJ);
    const bf16_t* XS = (const bf16_t*)(p->ws + WS_R2);
    const bf16_t* BN = (const bf16_t*)(p->ws + WS_BN); const bf16_t* CN = (const bf16_t*)(p->ws + WS_CN);
    const float* DT = (const float*)(p->ws + WS_DT);
    bf16_t* Y = (bf16_t*)(p->ws + WS_R1); float* GSQ = (float*)(p->ws + WS_GSQ);
    const float* s0 = p->in[2] + ((size_t)(bs * 32 + 8 * g) * 64 + p0) * 128 + 4 * n4;
    float* s1 = p->out + O_SSDS + ((size_t)(bs * 32 + 8 * g) * 64 + p0) * 128 + 4 * n4;
    f32x4 cur[8], nxt[8];
#pragma unroll
    for (int j = 0; j < 8; ++j) cur[j] = *(const f32x4*)(s0 + (size_t)(j >> 2) * 8192 + (size_t)(j & 3) * 2048);
    xsf[tid] = bf2f(XS[(size_t)row * 2048 + 512 * g + tid]);
    zsf[tid] = bf2f(proj[(size_t)row * NPROJ + C_ZA + 512 * g + tid]);
    if (tid < 8) { const int h = 8 * g + tid; const float dt = DT[(size_t)row * 32 + h]; hsc[tid * 4] = dt; hsc[tid * 4 + 1] = __expf(-dt * expf(p->in[12][h])); hsc[tid * 4 + 2] = p->in[13][h]; }
    const u32x2 bw = *(const u32x2*)(BN + (size_t)row * 512 + g * 128 + 4 * n4), cw = *(const u32x2*)(CN + (size_t)row * 512 + g * 128 + 4 * n4);
    const f32x4 Bv = (f32x4){lo_bf(bw.x), hi_bf(bw.x), lo_bf(bw.y), hi_bf(bw.y)}, Cv = (f32x4){lo_bf(cw.x), hi_bf(cw.x), lo_bf(cw.y), hi_bf(cw.y)};
    __syncthreads();
#pragma unroll
    for (int hp = 0; hp < 4; ++hp) {
        if (hp < 3) {
#pragma unroll
            for (int j = 0; j < 8; ++j) nxt[j] = *(const f32x4*)(s0 + (size_t)(2 * hp + 2 + (j >> 2)) * 8192 + (size_t)(j & 3) * 2048);
        }
#pragma unroll
        for (int j = 0; j < 8; ++j) {
            const int hh = 2 * hp + (j >> 2), pp = p0 + 16 * (j & 3);
            const float dt = hsc[hh * 4], dA = hsc[hh * 4 + 1], Dh = hsc[hh * 4 + 2];
            const float x = xsf[hh * 64 + pp], dtx = dt * x;
            const f32x4 hn = dA * cur[j] + dtx * Bv;
            *(f32x4*)(s1 + (size_t)hh * 8192 + (size_t)(j & 3) * 2048) = hn;
            float part = Cv[0] * hn[0] + Cv[1] * hn[1] + Cv[2] * hn[2] + Cv[3] * hn[3];
            part = red16_dpp(part); part += __shfl_xor(part, 16);
            if (n4 == 0) ybuf[hh * 64 + pp] = (part + Dh * x) * zsf[hh * 64 + pp];
        }
        if (hp < 3) {
#pragma unroll
            for (int j = 0; j < 8; ++j) cur[j] = nxt[j];
        }
    }
    __syncthreads();
    const float v = ybuf[tid];
    Y[(size_t)row * 2048 + 512 * g + tid] = f2bf(v);
    float sq = v * v;
#pragma unroll
    for (int o = 32; o >= 1; o >>= 1) sq += __shfl_xor(sq, o);
    if ((tid & 63) == 0) red[tid >> 6] = sq;
    __syncthreads();
    if (tid < 8) { float t = 0.f; if (tid == 0) for (int i = 0; i < 8; ++i) t += red[i]; GSQ[(size_t)row * 32 + 8 * g + tid] = t; }
    __syncthreads();
}

__device__ __forceinline__ void phase3(PP p, LAS unsigned char* lds, const int it_lo = 0, const int it_hi = 960) {
    LAS int* qslot = (LAS int*)(lds + LDS_BYTES - 16);
    unsigned* ctr = (unsigned*)(p->ws + WS_CTL);
    for (;;) {
        __syncthreads();
        if (threadIdx.x == 0) *qslot = (int)atomicAdd(ctr, 1u);
        __syncthreads();
        const int it = __builtin_amdgcn_readfirstlane(*qslot) + it_lo;
        if (it >= it_hi) break;
        int tid = threadIdx.x; asm volatile("" : "+v"(tid));
        if (it < 128) ssd_prompt_unit(p, lds, it >> 5, it & 31, tid);
        else if (it < 384) s5_unit(p, lds, (it - 128) >> 6, (it - 128) & 63, tid);
        else if (it < 448) s5_unit(p, lds, 4, it - 384, tid);
        else ssd_sample_unit(p, lds, (it - 448) >> 2, (it - 448) & 3, tid);
    }
}

__device__ __forceinline__ void ynorm_fix(PP p, LAS unsigned char* lds, const int tid) {
    const int wid = tid >> 6, lane = tid & 63;
    LAS int* qslot = (LAS int*)(lds + LDS_BYTES - 16);
    unsigned* ctr = (unsigned*)(p->ws + WS_CTL) + 1;
    bf16_t* Y = (bf16_t*)(p->ws + WS_R1); const float* GSQ = (const float*)(p->ws + WS_GSQ); const float* nw = p->in[14];
    for (;;) {
        __syncthreads();
        if (tid == 0) *qslot = (int)atomicAdd(ctr, 1u);
        __syncthreads();
        const int it = *qslot;
        if (it >= 1040) break;
        const int r = it * 8 + wid;
#pragma unroll
        for (int i = 0; i < 4; ++i) {
            const f32x4 q0 = *(const f32x4*)(GSQ + (size_t)r * 32 + 8 * i), q1 = *(const f32x4*)(GSQ + (size_t)r * 32 + 8 * i + 4);
            const float rs = rsqrtf(((q0[0] + q0[1]) + (q0[2] + q0[3]) + (q1[0] + q1[1]) + (q1[2] + q1[3])) * (1.0f / 512.0f) + 1e-5f);
            u32x4* ptr = (u32x4*)(Y + (size_t)r * 2048) + i * 64 + lane;
            const u32x4 v = *ptr;
            const f32x4 w0 = *(const f32x4*)(nw + (i * 64 + lane) * 8), w1 = *(const f32x4*)(nw + (i * 64 + lane) * 8 + 4);
            u32x4 o;
            o.x = cvt_pk_bf16(lo_bf(v.x) * rs * w0[0], hi_bf(v.x) * rs * w0[1]); o.y = cvt_pk_bf16(lo_bf(v.y) * rs * w0[2], hi_bf(v.y) * rs * w0[3]);
            o.z = cvt_pk_bf16(lo_bf(v.z) * rs * w1[0], hi_bf(v.z) * rs * w1[1]); o.w = cvt_pk_bf16(lo_bf(v.w) * rs * w1[2], hi_bf(v.w) * rs * w1[3]);
            *ptr = o;
        }
    }
}

__device__ __forceinline__ void phase7(PP p, const int tid) {
    const int wid = tid >> 6, lane = tid & 63;
    const float* rowsq = (const float*)(p->ws + WS_ROWSQ); const float* fw = p->in[28];
    for (int r = blockIdx.x * 8 + wid; r < 8320; r += gridDim.x * 8) {
        float ssq = lane < 32 ? rowsq[(size_t)r * 32 + lane] : 0.f;
#pragma unroll
        for (int o = 16; o >= 1; o >>= 1) ssq += __shfl_xor(ssq, o);
        ssq = __shfl(ssq, 0);
        const float rs = rsqrtf(ssq * (1.0f / 2048.0f) + 1e-5f);
        f32x4* ptr = (f32x4*)(p->out + (size_t)r * 2048);
#pragma unroll
        for (int i = 0; i < 8; ++i) { const f32x4 w = ((const f32x4*)fw)[i * 64 + lane]; f32x4 v = ptr[i * 64 + lane]; v = v * rs * w; ptr[i * 64 + lane] = v; }
    }
}

__global__ void __launch_bounds__(512) mk_fwd(Params pa, int ph_lo, int ph_hi) {
    extern __shared__ __attribute__((aligned(16))) unsigned char smem[];
    LAS unsigned char* lds = (LAS unsigned char*)smem;
    cg::grid_group grid = cg::this_grid();
#define PH_BEGIN(k) if (ph_lo <= (k) && (k) < ph_hi) { if (ph_lo < (k)) grid.sync();
#define PH_ENV PP p = (PP)__builtin_amdgcn_kernarg_segment_ptr(); asm volatile("" : "+s"(p)); int tid = threadIdx.x; asm volatile("" : "+v"(tid)); \
        const bf16_t* PROJ = (const bf16_t*)(p->ws + WS_PROJ); (void)PROJ;
#define PH_END }
#define BODY0 { PH_ENV phase0(p, lds, tid); }
#define BODY1 { PH_ENV \
        pg8::Gemm g{(const bf16_t*)(p->ws + WS_R1), (const bf16_t*)(p->ws + WS_WTIN), MP, NPROJ, 2048}; \
        pg8::StaticOrder S; S.init(MP, NPROJ, gridDim.x, blockIdx.x); \
        EpiProj E{(bf16_t*)(p->ws + WS_PROJ), (float*)(p->ws + WS_DT)}; \
        pg8::gemm_phase(lds, g, S, E, tid); }
#define BODY2 { PH_ENV phase2(p, tid); }
#define BODY3 { PH_ENV phase3(p, lds); }
#define BODY4 { PH_ENV \
        pg8::Gemm g{(const bf16_t*)(p->ws + WS_YB), (const bf16_t*)(p->ws + WS_WTGLU), MP, 1024, 1024}; \
        pg8::StaticOrder S; S.init(MP, 1024, gridDim.x, blockIdx.x); \
        EpiGlu E{(const bf16_t*)(p->ws + WS_YB), PROJ, p->in[25], (bf16_t*)(p->ws + WS_YB2)}; \
        pg8::gemm_phase(lds, g, S, E, tid); \
        ynorm_fix(p, lds, tid); }
#define BODY5 { PH_ENV \
        pg8::StaticOrder S; S.init(MP, 2048, gridDim.x, blockIdx.x); \
        { pg8::Gemm g{(const bf16_t*)(p->ws + WS_R1), (const bf16_t*)(p->ws + WS_WTA), MP, 2048, 2048}; \
          EpiMix<0> E{PROJ, nullptr, (bf16_t*)(p->ws + WS_R3)}; \
          pg8::gemm_phase(lds, g, S, E, tid); } \
        { pg8::Gemm g{(const bf16_t*)(p->ws + WS_YB2), (const bf16_t*)(p->ws + WS_WTB), MP, 2048, 1024}; \
          EpiMix<1> E{PROJ, (const bf16_t*)(p->ws + WS_R3), (bf16_t*)(p->ws + WS_R2)}; \
          pg8::gemm_phase(lds, g, S, E, tid); } }
#define BODY6 { PH_ENV \
        pg8::Gemm g{(const bf16_t*)(p->ws + WS_R2), (const bf16_t*)(p->ws + WS_WTOUT), MP, 2048, 2048}; \
        pg8::StaticOrder S; S.init(MP, 2048, gridDim.x, blockIdx.x); \
        EpiOut E{p->in[0], p->in[1], p->out, (float*)(p->ws + WS_ROWSQ)}; \
        pg8::gemm_phase(lds, g, S, E, tid); }
#define BODY7 { PH_ENV phase7(p, tid); }
    PH_BEGIN(0) BODY0 PH_END
#if DUP_PH == 0
    grid.sync(); BODY0
#endif
    PH_BEGIN(1) BODY1 PH_END
#if DUP_PH == 1
    grid.sync(); BODY1
#endif
    PH_BEGIN(2) BODY2 PH_END
    PH_BEGIN(3) BODY3 PH_END
#if DUP_PH == 3
    grid.sync();
    { if (blockIdx.x == 0 && threadIdx.x == 0) *(unsigned*)(pa.ws + WS_CTL) = 0u; }
    grid.sync(); { PH_ENV phase3(p, lds, DUP_LO, DUP_HI); }
#endif
    PH_BEGIN(4) BODY4 PH_END
    PH_BEGIN(5) BODY5 PH_END
#if DUP_PH == 5
    grid.sync(); BODY5
#endif
    PH_BEGIN(6) BODY6 PH_END
    PH_BEGIN(7) BODY7 PH_END
}

extern "C" void kernel_launch(void* const* d_in, const int* in_sizes, int n_in, void* d_out, int out_size, void* d_ws, size_t ws_size, hipStream_t stream) {
    static int grid_blocks = 0;
    if (grid_blocks == 0) {
        if (n_in != 29 || ws_size < WS_END) { fprintf(stderr, "kernel_launch: unexpected n_in %d or ws_size %zu (< %zu)\n", n_in, ws_size, (size_t)WS_END); grid_blocks = -1; return; }
        int dev = 0, cus = 0, per_cu = 0;
        hipGetDevice(&dev);
        hipDeviceGetAttribute(&cus, hipDeviceAttributeMultiprocessorCount, dev);
        if (hipFuncSetAttribute((const void*)mk_fwd, hipFuncAttributeMaxDynamicSharedMemorySize, LDS_BYTES) != hipSuccess) { fprintf(stderr, "kernel_launch: hipFuncSetAttribute failed\n"); grid_blocks = -1; return; }
        if (hipOccupancyMaxActiveBlocksPerMultiprocessor(&per_cu, (const void*)mk_fwd, 512, LDS_BYTES) != hipSuccess || per_cu < 1) { fprintf(stderr, "kernel_launch: occupancy query gave %d\n", per_cu); per_cu = 1; (void)hipGetLastError(); }
        grid_blocks = cus * per_cu;
    }
    if (grid_blocks < 0) return;
    Params p{};
    for (int i = 0; i < 29; ++i) p.in[i] = (const float*)d_in[i];
    p.out = (float*)d_out; p.ws = (unsigned char*)d_ws;
#if ONE_LAUNCH
    int lo = 0, hi = 8;
    void* args[] = {&p, &lo, &hi};
    hipError_t e = hipLaunchCooperativeKernel((const void*)mk_fwd, dim3(grid_blocks), dim3(512), args, LDS_BYTES, stream);
    if (e != hipSuccess) fprintf(stderr, "cooperative launch failed: %s (grid %d)\n", hipGetErrorString(e), grid_blocks);
#else
    for (int ph = 0; ph < 8; ++ph) hipLaunchKernelGGL(mk_fwd, dim3(grid_blocks), dim3(512), LDS_BYTES, stream, p, ph, ph + 1);
#endif
}
```

```cpp
#include <hip/hip_runtime.h>
#include <hip/hip_cooperative_groups.h>
#include <cstdio>
namespace cg = cooperative_groups;

#define DUP_PH -1
#define DUP_LO 0
#define DUP_HI 128
#ifndef ONE_LAUNCH
#define ONE_LAUNCH 1
#endif

#define LAS __attribute__((address_space(3)))
typedef unsigned short bf16_t;
typedef short bf16x8 __attribute__((ext_vector_type(8)));
typedef float f32x4 __attribute__((ext_vector_type(4)));
typedef float f32x2 __attribute__((ext_vector_type(2)));
typedef unsigned u32x4 __attribute__((ext_vector_type(4)));
typedef unsigned u32x2 __attribute__((ext_vector_type(2)));

constexpr int MP = 8448;
constexpr int NPROJ = 11520;
constexpr int C_ZA = 0, C_XBC = 2048, C_UB = 5120, C_ZB = 6144, C_GA = 7168, C_GB = 9216, C_DT = 11264;
constexpr int LDS_BYTES = 139264;

constexpr size_t O_YP = 0, O_YS = 16777216, O_SSDP = 17039360, O_CONVP = 18087936, O_S5RP = 18124800, O_S5IP = 18141184,
                 O_SSDS = 18157568, O_CONVS = 51712000, O_S5RS = 52891648, O_S5IS = 53415936;

constexpr size_t WS_CTL = 0;
constexpr size_t WS_ROWSQ = 4096;
constexpr size_t WS_GSQ = WS_ROWSQ + (size_t)MP * 32 * 4;
constexpr size_t WS_DT = WS_GSQ + (size_t)MP * 32 * 4;
constexpr size_t WS_WTIN = WS_DT + 1081344;
constexpr size_t WS_WTA = WS_WTIN + (size_t)NPROJ * 2048 * 2;
constexpr size_t WS_WTGLU = WS_WTA + (size_t)2048 * 2048 * 2;
constexpr size_t WS_WTB = WS_WTGLU + (size_t)1024 * 1024 * 2;
constexpr size_t WS_WTOUT = WS_WTB + (size_t)2048 * 1024 * 2;
constexpr size_t WS_R1 = WS_WTOUT + (size_t)2048 * 2048 * 2;
constexpr size_t WS_R2 = WS_R1 + (size_t)MP * 2048 * 2;
constexpr size_t WS_R3 = WS_R2 + (size_t)MP * 2048 * 2;
constexpr size_t WS_PROJ = WS_R3 + (size_t)MP * 2048 * 2;
constexpr size_t WS_BN = WS_PROJ + (size_t)MP * NPROJ * 2;
constexpr size_t WS_CN = WS_BN + (size_t)MP * 512 * 2;
constexpr size_t WS_BT = WS_CN + (size_t)MP * 512 * 2;
constexpr size_t WS_YB = WS_BT + (size_t)MP * 512 * 2;
constexpr size_t WS_YB2 = WS_YB + (size_t)MP * 1024 * 2;
constexpr size_t WS_END = WS_YB2 + (size_t)MP * 1024 * 2;

struct Params {
    const float* in[29];
    float* out;
    unsigned char* ws;
};
typedef const __attribute__((address_space(4))) Params* PP;

__device__ __forceinline__ float bf2f(bf16_t b) { return __uint_as_float(((unsigned)b) << 16); }
__device__ __forceinline__ bf16_t f2bf(float f) { unsigned u = __float_as_uint(f); u += 0x7FFFu + ((u >> 16) & 1u); return (bf16_t)(u >> 16); }
__device__ __forceinline__ unsigned cvt_pk_bf16(float lo, float hi) { unsigned r; asm volatile("v_cvt_pk_bf16_f32 %0, %1, %2" : "=v"(r) : "v"(lo), "v"(hi)); return r; }
__device__ __forceinline__ float lo_bf(unsigned w) { return __uint_as_float(w << 16); }
__device__ __forceinline__ float hi_bf(unsigned w) { return __uint_as_float(w & 0xffff0000u); }
__device__ __forceinline__ float sigmoidf_(float x) { return __builtin_amdgcn_rcpf(1.0f + __expf(-x)); }
__device__ __forceinline__ float siluf_(float x) { return x * sigmoidf_(x); }
__device__ __forceinline__ float gelu_tanh(float x) {
    const float u = 0.7978845608028654f * (x + 0.044715f * x * x * x);
    const float e = __expf(2.0f * u);
    const float t = 1.0f - 2.0f * __builtin_amdgcn_rcpf(1.0f + e);
    return 0.5f * x * (1.0f + t);
}
__device__ __forceinline__ float softplusf_(float x) { return fmaxf(x, 0.0f) + log1pf(__expf(-fabsf(x))); }
__device__ __forceinline__ int prow(int b, int tp) { return tp < 16 ? (8320 + tp) : (b * 2048 + tp - 16); }

__device__ __forceinline__ float red16_dpp(float v) {
    v += __int_as_float(__builtin_amdgcn_update_dpp(0, __float_as_int(v), 0xB1, 0xF, 0xF, true));
    v += __int_as_float(__builtin_amdgcn_update_dpp(0, __float_as_int(v), 0x4E, 0xF, 0xF, true));
    v += __int_as_float(__builtin_amdgcn_update_dpp(0, __float_as_int(v), 0x141, 0xF, 0xF, true));
    v += __int_as_float(__builtin_amdgcn_update_dpp(0, __float_as_int(v), 0x140, 0xF, 0xF, true));
    return v;
}

__device__ __forceinline__ double d_exp(double x) {
    const double kf = __builtin_rint(x * 1.4426950408889634);
    const double r = (x - kf * 0.693147180369123816490e+00) - kf * 1.90821492927058770002e-10;
    double s = 1.0 / 6227020800.0;
    s = s * r + 1.0 / 479001600.0;
    s = s * r + 1.0 / 39916800.0;
    s = s * r + 1.0 / 3628800.0;
    s = s * r + 1.0 / 362880.0;
    s = s * r + 1.0 / 40320.0;
    s = s * r + 1.0 / 5040.0;
    s = s * r + 1.0 / 720.0;
    s = s * r + 1.0 / 120.0;
    s = s * r + 1.0 / 24.0;
    s = s * r + 1.0 / 6.0;
    s = s * r + 0.5;
    s = s * r + 1.0;
    s = s * r + 1.0;
    const long long bits = ((long long)((int)kf + 1023)) << 52;
    return s * __longlong_as_double(bits);
}
__device__ __forceinline__ void d_sincos(double x, double& sn, double& cs) {
    const double kf = __builtin_rint(x * 0.63661977236758134308);
    const double y = (x - kf * 1.57079632673412561417e+00) - kf * 6.07710050650619224932e-11;
    const double y2 = y * y;
    double ps = -1.0 / 1307674368000.0;
    ps = ps * y2 + 1.0 / 6227020800.0;
    ps = ps * y2 - 1.0 / 39916800.0;
    ps = ps * y2 + 1.0 / 362880.0;
    ps = ps * y2 - 1.0 / 5040.0;
    ps = ps * y2 + 1.0 / 120.0;
    ps = ps * y2 - 1.0 / 6.0;
    ps = ps * y2 + 1.0;
    const double s0 = y * ps;
    double pc = 1.0 / 20922789888000.0;
    pc = pc * y2 - 1.0 / 87178291200.0;
    pc = pc * y2 + 1.0 / 479001600.0;
    pc = pc * y2 - 1.0 / 3628800.0;
    pc = pc * y2 + 1.0 / 40320.0;
    pc = pc * y2 - 1.0 / 720.0;
    pc = pc * y2 + 1.0 / 24.0;
    pc = pc * y2 - 0.5;
    pc = pc * y2 + 1.0;
    const int q = ((int)kf) & 3;
    sn = (q == 0) ? s0 : (q == 1) ? pc : (q == 2) ? -s0 : -pc;
    cs = (q == 0) ? pc : (q == 1) ? -s0 : (q == 2) ? -pc : s0;
}

namespace pg8 {
constexpr int BM = 256, BK = 64, HALF = 128, HTB = HALF * BK * 2, STAGE_BYTES = 8 * HTB, NXCD = 8, WGM = 8;
__device__ __forceinline__ int lds_byte(int r, int c) { const int st = (r >> 4) * 2 + (c >> 5), rr = r & 15, cc = c & 31, ob = rr * 64 + cc * 2; return st * 1024 + (ob ^ (((ob >> 9) & 1) << 5)); }
__device__ __forceinline__ void stage_rc(int b, int& R, int& C) { const int st = b / 1024, sb = b % 1024, swz = sb ^ (((sb >> 9) & 1) << 5); R = (st >> 1) * 16 + swz / 64; C = (st & 1) * 32 + (swz % 64) / 2; }
__device__ __forceinline__ int perm32(int rho) { const int n = rho >> 4, i = rho & 15; return 8 * (i >> 2) + 4 * n + (i & 3); }
struct Unit { int pm, pn; };
struct Gemm { const bf16_t* A; const bf16_t* Bt; int M, N, K; };
struct StaticOrder {
    int nM, nN, nwg, G, c;
    __device__ void init(int M, int N, int G_, int c_) { nM = M / BM; nN = N / BM; nwg = nM * nN; G = G_; c = c_; }
    __device__ bool next(int i, Unit& u) const {
        const long L = (long)i * G + c; if (L >= nwg) return false;
        int wgid = (int)L; { const int q = nwg / NXCD, r = nwg % NXCD, xcd = wgid % NXCD, off = wgid / NXCD; wgid = (xcd < r ? xcd * (q + 1) : r * (q + 1) + (xcd - r) * q) + off; }
        const int nig = WGM * nN, gid = wgid / nig, fm = gid * WGM, gsz = (nM - fm) < WGM ? (nM - fm) : WGM;
        u.pm = fm + ((wgid % nig) % gsz); u.pn = (wgid % nig) / gsz; return true;
    }
};
template <class Epi, class Sched>
__device__ __forceinline__ void gemm_phase(LAS unsigned char* lds, const Gemm g, const Sched& S, const Epi& E, const int tid) {
    const int wid = __builtin_amdgcn_readfirstlane(tid >> 6), lane = tid & 63, wr = wid >> 2, wc = wid & 3, fr = lane & 15, fq = lane >> 4;
    const int K = g.K, nt = K / BK;
    unsigned voffA[2], voffB[2];
#pragma unroll
    for (int i = 0; i < 2; ++i) { int R, C; stage_rc(tid * 16 + i * 8192, R, C); const int Rb = Epi::PERM ? ((R & ~31) + perm32(R & 31)) : R;
        voffA[i] = (unsigned)(R * K + C) * 2u; voffB[i] = (unsigned)(Rb * K + C) * 2u; }
    const size_t kstep = (size_t)(BK * 2);
    const size_t hstep = (size_t)HALF * K * 2;
    const size_t tstep = 2 * hstep;
    const unsigned ldsw = (unsigned)wid * 1024u;
    const int aoff = lds_byte(wr * 64 + fr, fq * 8), boff = lds_byte(wc * 32 + fr, fq * 8);
#define PG8_SA(b, h) (((b) * 2 + (h)) * HTB)
#define PG8_SB(b, h) ((4 + (b) * 2 + (h)) * HTB)
#define PG8_STAGE(bufoff, gbase, voff) do { _Pragma("unroll") for (int _i = 0; _i < 2; ++_i) \
        __builtin_amdgcn_global_load_lds((const unsigned*)((const char*)(gbase) + (voff)[_i]), (LAS unsigned*)(lds + (bufoff) + ldsw + _i * 8192), 16, 0, 0); } while (0)
#define PG8_LDA(dst, b, h) do { _Pragma("unroll") for (int m = 0; m < 4; ++m) _Pragma("unroll") for (int k = 0; k < 2; ++k) dst[m][k] = *(const LAS bf16x8*)(lds + PG8_SA(b, h) + aoff + m * 2048 + k * 1024); } while (0)
#define PG8_LDB(dst, b, h) do { _Pragma("unroll") for (int n = 0; n < 2; ++n) _Pragma("unroll") for (int k = 0; k < 2; ++k) dst[n][k] = *(const LAS bf16x8*)(lds + PG8_SB(b, h) + boff + n * 2048 + k * 1024); } while (0)
#define PG8_MMA(ai, bj, At, Bt) do { __builtin_amdgcn_s_setprio(1); _Pragma("unroll") for (int m = 0; m < 4; ++m) _Pragma("unroll") for (int n = 0; n < 2; ++n) _Pragma("unroll") for (int k = 0; k < 2; ++k) \
        acc[ai][bj][m][n] = __builtin_amdgcn_mfma_f32_16x16x32_bf16(Bt[n][k], At[m][k], acc[ai][bj][m][n], 0, 0, 0); __builtin_amdgcn_s_setprio(0); } while (0)
#define PG8_WAIT_V(n) asm volatile("s_waitcnt vmcnt(" #n ")" ::: "memory")
#define PG8_WAIT_L(n) asm volatile("s_waitcnt lgkmcnt(" #n ")" ::: "memory")
#define PG8_BAR __builtin_amdgcn_s_barrier()
#define PG8_SCHED __builtin_amdgcn_sched_barrier(0)
    Unit cur, nxt; int ui = 0;
    if (!S.next(0, cur)) return;
    f32x4 acc[2][2][4][2];
#pragma unroll
    for (int a = 0; a < 2; ++a)
#pragma unroll
        for (int b = 0; b < 2; ++b)
#pragma unroll
            for (int m = 0; m < 4; ++m)
#pragma unroll
                for (int n = 0; n < 2; ++n) acc[a][b][m][n] = (f32x4){0.f, 0.f, 0.f, 0.f};
    bf16x8 At[4][2], B0[2][2], B1[2][2];
    const char* cA = (const char*)g.A + (size_t)cur.pm * tstep; const char* cB = (const char*)g.Bt + (size_t)cur.pn * tstep;
    PG8_STAGE(PG8_SB(0, 0), cB, voffB); PG8_STAGE(PG8_SA(0, 0), cA, voffA); PG8_STAGE(PG8_SB(0, 1), cB + hstep, voffB); PG8_STAGE(PG8_SA(0, 1), cA + hstep, voffA);
    if (wr == 1) PG8_BAR;
    PG8_WAIT_V(4); PG8_BAR;
    PG8_STAGE(PG8_SB(1, 0), cB + kstep, voffB); PG8_STAGE(PG8_SA(1, 0), cA + kstep, voffA); PG8_STAGE(PG8_SB(1, 1), cB + hstep + kstep, voffB);
    PG8_WAIT_V(6); PG8_BAR;
    for (;;) {
        const bool has_next = S.next(ui + 1, nxt);
        const char* nA = has_next ? (const char*)g.A + (size_t)nxt.pm * tstep : cA; const char* nB = has_next ? (const char*)g.Bt + (size_t)nxt.pn * tstep : cB;
        for (int t = 0; t < nt; t += 2) {
            const bool last = (t == nt - 2);
            const char* a1 = cA + (size_t)(t + 1) * kstep;
            const char* a2 = last ? nA : cA + (size_t)(t + 2) * kstep; const char* b2 = last ? nB : cB + (size_t)(t + 2) * kstep;
            const char* a3 = a2 + kstep; const char* b3 = b2 + kstep;
            PG8_LDB(B0, 0, 0); PG8_SCHED; PG8_LDA(At, 0, 0); PG8_STAGE(PG8_SA(1, 1), a1 + hstep, voffA);
            PG8_WAIT_L(8); PG8_BAR; PG8_WAIT_L(0); PG8_MMA(0, 0, At, B0); PG8_BAR; PG8_SCHED;
            PG8_LDB(B1, 0, 1); PG8_STAGE(PG8_SB(0, 0), b2, voffB);
            PG8_BAR; PG8_WAIT_L(0); PG8_MMA(0, 1, At, B1); PG8_BAR;
            PG8_LDA(At, 0, 1); PG8_STAGE(PG8_SA(0, 0), a2, voffA);
            PG8_BAR; PG8_WAIT_L(0); PG8_MMA(1, 0, At, B0); PG8_BAR; PG8_SCHED;
            PG8_STAGE(PG8_SB(0, 1), b2 + hstep, voffB);
            PG8_WAIT_V(6); PG8_BAR; PG8_MMA(1, 1, At, B1); PG8_BAR;
            PG8_LDB(B0, 1, 0); PG8_SCHED; PG8_LDA(At, 1, 0); PG8_STAGE(PG8_SA(0, 1), a2 + hstep, voffA);
            PG8_WAIT_L(8); PG8_BAR; PG8_WAIT_L(0); PG8_MMA(0, 0, At, B0); PG8_BAR; PG8_SCHED;
            PG8_LDB(B1, 1, 1); PG8_STAGE(PG8_SB(1, 0), b3, voffB);
            PG8_BAR; PG8_WAIT_L(0); PG8_MMA(0, 1, At, B1); PG8_BAR;
            PG8_LDA(At, 1, 1); PG8_STAGE(PG8_SA(1, 0), a3, voffA);
            PG8_BAR; PG8_WAIT_L(0); PG8_MMA(1, 0, At, B0); PG8_BAR; PG8_SCHED;
            PG8_STAGE(PG8_SB(1, 1), b3 + hstep, voffB);
            PG8_WAIT_V(6); PG8_BAR; PG8_MMA(1, 1, At, B1); PG8_BAR;
        }
        E(acc, cur, wr, wc, fr, fq);
        if (!has_next) break;
#pragma unroll
        for (int a = 0; a < 2; ++a)
#pragma unroll
            for (int b = 0; b < 2; ++b)
#pragma unroll
                for (int m = 0; m < 4; ++m)
#pragma unroll
                    for (int n = 0; n < 2; ++n) acc[a][b][m][n] = (f32x4){0.f, 0.f, 0.f, 0.f};
        cur = nxt; cA = nA; cB = nB; ++ui;
    }
    PG8_WAIT_V(0);
    if (wr == 0) PG8_BAR;
    PG8_BAR;
#undef PG8_SA
#undef PG8_SB
#undef PG8_STAGE
#undef PG8_LDA
#undef PG8_LDB
#undef PG8_MMA
#undef PG8_WAIT_V
#undef PG8_WAIT_L
#undef PG8_BAR
#undef PG8_SCHED
}
}
using pg8::Unit;

struct EpiProj {
    static constexpr bool PERM = true;
    bf16_t* O; float* DT;
    __device__ __forceinline__ void operator()(const f32x4 (&acc)[2][2][4][2], const Unit& u, int wr, int wc, int fr, int fq) const {
        const int row0 = u.pm * 256 + wr * 64 + fr, col0 = u.pn * 256 + wc * 32 + 8 * fq;
        const int act = (u.pn < 8 || (u.pn >= 24 && u.pn < 28)) ? 1 : ((u.pn >= 28 && u.pn < 44) ? 2 : 0);
#pragma unroll
        for (int ai = 0; ai < 2; ++ai)
#pragma unroll
            for (int m = 0; m < 4; ++m) {
                const int row = row0 + ai * 128 + m * 16;
                bf16_t* rowp = O + (size_t)row * NPROJ + col0;
#pragma unroll
                for (int bj = 0; bj < 2; ++bj) {
                    f32x4 v0 = acc[ai][bj][m][0], v1 = acc[ai][bj][m][1];
                    if (u.pn == 44 && bj == 0 && wc == 0) { float* d = DT + (size_t)row * 32 + 8 * fq; *(f32x4*)d = v0; *(f32x4*)(d + 4) = v1; }
                    if (act == 1) {
#pragma unroll
                        for (int j = 0; j < 4; ++j) { v0[j] = siluf_(v0[j]); v1[j] = siluf_(v1[j]); }
                    } else if (act == 2) {
#pragma unroll
                        for (int j = 0; j < 4; ++j) { v0[j] = sigmoidf_(v0[j]); v1[j] = sigmoidf_(v1[j]); }
                    }
                    u32x4 w; w.x = cvt_pk_bf16(v0[0], v0[1]); w.y = cvt_pk_bf16(v0[2], v0[3]); w.z = cvt_pk_bf16(v1[0], v1[1]); w.w = cvt_pk_bf16(v1[2], v1[3]);
                    *(u32x4*)(rowp + bj * 128) = w;
                }
            }
    }
};
struct EpiGlu {
    static constexpr bool PERM = true;
    const bf16_t* YB; const bf16_t* PROJ; const float* bias; bf16_t* O;
    __device__ __forceinline__ void operator()(const f32x4 (&acc)[2][2][4][2], const Unit& u, int wr, int wc, int fr, int fq) const {
        const int row0 = u.pm * 256 + wr * 64 + fr, col0 = u.pn * 256 + wc * 32 + 8 * fq;
#pragma unroll
        for (int bj = 0; bj < 2; ++bj) {
            const int col = col0 + bj * 128;
            const f32x4 b0 = *(const f32x4*)(bias + col), b1 = *(const f32x4*)(bias + col + 4);
#pragma unroll
            for (int ai = 0; ai < 2; ++ai)
#pragma unroll
                for (int m = 0; m < 4; ++m) {
                    const int row = row0 + ai * 128 + m * 16;
                    const u32x4 yb = *(const u32x4*)(YB + (size_t)row * 1024 + col);
                    const u32x4 zb = *(const u32x4*)(PROJ + (size_t)row * NPROJ + C_ZB + col);
                    const f32x4 v0 = acc[ai][bj][m][0] + b0, v1 = acc[ai][bj][m][1] + b1;
                    u32x4 w;
                    w.x = cvt_pk_bf16(lo_bf(yb.x) * sigmoidf_(v0[0]) * lo_bf(zb.x), hi_bf(yb.x) * sigmoidf_(v0[1]) * hi_bf(zb.x));
                    w.y = cvt_pk_bf16(lo_bf(yb.y) * sigmoidf_(v0[2]) * lo_bf(zb.y), hi_bf(yb.y) * sigmoidf_(v0[3]) * hi_bf(zb.y));
                    w.z = cvt_pk_bf16(lo_bf(yb.z) * sigmoidf_(v1[0]) * lo_bf(zb.z), hi_bf(yb.z) * sigmoidf_(v1[1]) * hi_bf(zb.z));
                    w.w = cvt_pk_bf16(lo_bf(yb.w) * sigmoidf_(v1[2]) * lo_bf(zb.w), hi_bf(yb.w) * sigmoidf_(v1[3]) * hi_bf(zb.w));
                    *(u32x4*)(O + (size_t)row * 1024 + col) = w;
                    asm volatile("" ::: "memory");
                }
        }
    }
};
template <int SECOND> struct EpiMix {
    static constexpr bool PERM = true;
    const bf16_t* PROJ; const bf16_t* PREV; bf16_t* O;
    __device__ __forceinline__ void operator()(const f32x4 (&acc)[2][2][4][2], const Unit& u, int wr, int wc, int fr, int fq) const {
        const int row0 = u.pm * 256 + wr * 64 + fr, col0 = u.pn * 256 + wc * 32 + 8 * fq;
#pragma unroll
        for (int ai = 0; ai < 2; ++ai)
#pragma unroll
            for (int m = 0; m < 4; ++m) {
                const int row = row0 + ai * 128 + m * 16;
#pragma unroll
                for (int bj = 0; bj < 2; ++bj) {
                    const int col = col0 + bj * 128;
                    const u32x4 gt = *(const u32x4*)(PROJ + (size_t)row * NPROJ + (SECOND ? C_GB : C_GA) + col);
                    const f32x4 v0 = acc[ai][bj][m][0], v1 = acc[ai][bj][m][1];
                    float o[8] = {lo_bf(gt.x) * v0[0], hi_bf(gt.x) * v0[1], lo_bf(gt.y) * v0[2], hi_bf(gt.y) * v0[3],
                                  lo_bf(gt.z) * v1[0], hi_bf(gt.z) * v1[1], lo_bf(gt.w) * v1[2], hi_bf(gt.w) * v1[3]};
                    if (SECOND) {
                        const u32x4 pv = *(const u32x4*)(PREV + (size_t)row * 2048 + col);
                        o[0] += lo_bf(pv.x); o[1] += hi_bf(pv.x); o[2] += lo_bf(pv.y); o[3] += hi_bf(pv.y);
                        o[4] += lo_bf(pv.z); o[5] += hi_bf(pv.z); o[6] += lo_bf(pv.w); o[7] += hi_bf(pv.w);
                    }
                    u32x4 w; w.x = cvt_pk_bf16(o[0], o[1]); w.y = cvt_pk_bf16(o[2], o[3]); w.z = cvt_pk_bf16(o[4], o[5]); w.w = cvt_pk_bf16(o[6], o[7]);
                    *(u32x4*)(O + (size_t)row * 2048 + col) = w;
                    asm volatile("" ::: "memory");
                }
            }
    }
};
struct EpiOut {
    static constexpr bool PERM = false;
    const float* xp; const float* xs; float* out; float* rowsq;
    __device__ __forceinline__ void operator()(const f32x4 (&acc)[2][2][4][2], const Unit& u, int wr, int wc, int fr, int fq) const {
        const int row0 = u.pm * 256 + wr * 64 + fr, col0 = u.pn * 256 + wc * 32 + 4 * fq;
#pragma unroll
        for (int ai = 0; ai < 2; ++ai)
#pragma unroll
            for (int m = 0; m < 4; ++m) {
                const int row = row0 + ai * 128 + m * 16;
                const bool ok = row < 8320;
                const float* hp = row < 8192 ? xp + (size_t)row * 2048 : xs + (size_t)(ok ? row - 8192 : 0) * 2048;
                float s = 0.f;
                if (ok) {
#pragma unroll
                    for (int bj = 0; bj < 2; ++bj)
#pragma unroll
                        for (int n = 0; n < 2; ++n) {
                            const int col = col0 + bj * 128 + n * 16;
                            const f32x4 o = *(const f32x4*)(hp + col) + acc[ai][bj][m][n];
                            *(f32x4*)(out + (size_t)row * 2048 + col) = o;
                            s += o[0] * o[0] + o[1] * o[1] + o[2] * o[2] + o[3] * o[3];
                        }
                }
                s += __shfl_xor(s, 16); s += __shfl_xor(s, 32);
                if (ok && fq == 0) rowsq[(size_t)row * 32 + u.pn * 4 + wc] = s;
            }
    }
};

__device__ __forceinline__ int remap_in(int n) { return n < 5120 ? n : (n < 5152 ? C_DT + (n - 5120) : n - 32); }
__device__ __forceinline__ void phase0(PP p, LAS unsigned char* lds, const int tid) {
    const int bid = blockIdx.x, nb = gridDim.x, wid = tid >> 6, lane = tid & 63;
    {
        unsigned* ctl = (unsigned*)(p->ws + WS_CTL);
        if (bid == 0 && tid < 64) ctl[tid] = 0u;
    }
    {
        bf16_t* xn = (bf16_t*)(p->ws + WS_R1); const float* nw = p->in[7];
        for (int r = bid * 8 + wid; r < MP; r += nb * 8) {
            const float* src = nullptr;
            if (r < 8192) src = p->in[0] + (size_t)r * 2048;
            else if (r < 8320) src = p->in[1] + (size_t)(r - 8192) * 2048;
            else if (r < 8336) src = p->in[6] + (size_t)(r - 8320) * 2048;
            u32x2* dst = (u32x2*)(xn + (size_t)r * 2048);
            if (!src) {
#pragma unroll
                for (int i = 0; i < 8; ++i) dst[i * 64 + lane] = (u32x2){0u, 0u};
                continue;
            }
            f32x4 v[8]; float ss = 0.f;
#pragma unroll
            for (int i = 0; i < 8; ++i) { v[i] = ((const f32x4*)src)[i * 64 + lane]; ss += v[i][0] * v[i][0] + v[i][1] * v[i][1] + v[i][2] * v[i][2] + v[i][3] * v[i][3]; }
#pragma unroll
            for (int o = 32; o >= 1; o >>= 1) ss += __shfl_xor(ss, o);
            const float rs = rsqrtf(ss * (1.0f / 2048.0f) + 1e-5f);
#pragma unroll
            for (int i = 0; i < 8; ++i) { const f32x4 w = ((const f32x4*)nw)[i * 64 + lane]; u32x2 o; o.x = cvt_pk_bf16(v[i][0] * rs * w[0], v[i][1] * rs * w[1]); o.y = cvt_pk_bf16(v[i][2] * rs * w[2], v[i][3] * rs * w[3]); dst[i * 64 + lane] = o; }
        }
    }
    {
        LAS float* tile = (LAS float*)lds;
#define WT_DECODE(job_, src_, dst_, N_, K_, n0_, k0_, remap_) do { int j_ = (job_); int nt_, kt_; remap_ = false; \
            if (j_ < 5648) { src_ = p->in[8]; dst_ = (bf16_t*)(p->ws + WS_WTIN); N_ = 11296; K_ = 2048; nt_ = j_ >> 4; kt_ = j_ & 15; remap_ = true; } \
            else if ((j_ -= 5648) < 1024) { src_ = p->in[15]; dst_ = (bf16_t*)(p->ws + WS_WTA); N_ = 2048; K_ = 2048; nt_ = j_ >> 4; kt_ = j_ & 15; } \
            else if ((j_ -= 1024) < 256) { src_ = p->in[24]; dst_ = (bf16_t*)(p->ws + WS_WTGLU); N_ = 1024; K_ = 1024; nt_ = j_ >> 3; kt_ = j_ & 7; } \
            else if ((j_ -= 256) < 512) { src_ = p->in[26]; dst_ = (bf16_t*)(p->ws + WS_WTB); N_ = 2048; K_ = 1024; nt_ = j_ >> 3; kt_ = j_ & 7; } \
            else { j_ -= 512; src_ = p->in[27]; dst_ = (bf16_t*)(p->ws + WS_WTOUT); N_ = 2048; K_ = 2048; nt_ = j_ >> 4; kt_ = j_ & 15; } \
            n0_ = nt_ * 32; k0_ = kt_ * 128; } while (0)
        const int kr0 = tid >> 3, c4 = tid & 7;
        int job = bid;
        const float* src; bf16_t* dst; int N, K, n0, k0; bool remap;
        f32x4 v0 = (f32x4){0.f, 0.f, 0.f, 0.f}, v1 = v0;
        if (job < 8464) { WT_DECODE(job, src, dst, N, K, n0, k0, remap);
            v0 = *(const f32x4*)(src + (size_t)(k0 + kr0) * N + n0 + c4 * 4); v1 = *(const f32x4*)(src + (size_t)(k0 + kr0 + 64) * N + n0 + c4 * 4); }
        while (job < 8464) {
            tile[kr0 * 33 + c4 * 4 + 0] = v0[0]; tile[kr0 * 33 + c4 * 4 + 1] = v0[1]; tile[kr0 * 33 + c4 * 4 + 2] = v0[2]; tile[kr0 * 33 + c4 * 4 + 3] = v0[3];
            tile[(kr0 + 64) * 33 + c4 * 4 + 0] = v1[0]; tile[(kr0 + 64) * 33 + c4 * 4 + 1] = v1[1]; tile[(kr0 + 64) * 33 + c4 * 4 + 2] = v1[2]; tile[(kr0 + 64) * 33 + c4 * 4 + 3] = v1[3];
            bf16_t* cdst = dst; const int cK = K, cn0 = n0, ck0 = k0; const bool cremap = remap;
            job += nb;
            if (job < 8464) { WT_DECODE(job, src, dst, N, K, n0, k0, remap);
                v0 = *(const f32x4*)(src + (size_t)(k0 + kr0) * N + n0 + c4 * 4); v1 = *(const f32x4*)(src + (size_t)(k0 + kr0 + 64) * N + n0 + c4 * 4); }
            __syncthreads();
            { const int n = tid >> 4, k8 = tid & 15; float f[8];
#pragma unroll
              for (int q = 0; q < 8; ++q) f[q] = tile[(k8 * 8 + q) * 33 + n];
              int nd = cn0 + n; if (cremap) nd = remap_in(nd);
              u32x4 o; o.x = cvt_pk_bf16(f[0], f[1]); o.y = cvt_pk_bf16(f[2], f[3]); o.z = cvt_pk_bf16(f[4], f[5]); o.w = cvt_pk_bf16(f[6], f[7]);
              *(u32x4*)(cdst + (size_t)nd * cK + ck0 + k8 * 8) = o; }
            __syncthreads();
        }
#undef WT_DECODE
    }
}

__device__ __forceinline__ void phase2(PP p, const int tid) {
    const int wid = tid >> 6, lane = tid & 63;
    const int gw = blockIdx.x * 8 + wid, nw = gridDim.x * 8;
    const bf16_t* proj = (const bf16_t*)(p->ws + WS_PROJ);
    bf16_t* XS = (bf16_t*)(p->ws + WS_R2); bf16_t* XT = (bf16_t*)(p->ws + WS_R3);
    bf16_t* BN = (bf16_t*)(p->ws + WS_BN); bf16_t* CN = (bf16_t*)(p->ws + WS_CN); bf16_t* BT = (bf16_t*)(p->ws + WS_BT);
    const float* cw = p->in[9]; const float* cb = p->in[10];
#define CONV_LOAD(it_, dstv_) do { const int cblk_ = (it_) % 48, r_ = (it_) / 48, tau8_ = r_ % 264, b_ = r_ / 264; const int ch_ = cblk_ * 64 + lane, tp0_ = tau8_ * 8 - 48; \
        _Pragma("unroll") for (int k_ = 0; k_ < 11; ++k_) { const int tp_ = tp0_ - 3 + k_; dstv_[k_] = (tp0_ >= 0 && tp_ >= 0) ? proj[(size_t)prow(b_, tp_) * NPROJ + C_XBC + ch_] : (bf16_t)0; } } while (0)
    {
        bf16_t cur[11], nxt[11];
#pragma unroll
        for (int k = 0; k < 11; ++k) { cur[k] = 0; nxt[k] = 0; }
        if (gw < 4 * 264 * 48) CONV_LOAD(gw, cur);
        for (int it = gw; it < 4 * 264 * 48; it += nw) {
            if (it + nw < 4 * 264 * 48) CONV_LOAD(it + nw, nxt);
            const int cblk = it % 48, r = it / 48, tau8 = r % 264, b = r / 264;
            const int ch = cblk * 64 + lane;
            const int tp0 = tau8 * 8 - 48;
            float ov[8];
            if (tp0 < 0) {
#pragma unroll
                for (int j = 0; j < 8; ++j) ov[j] = 0.f;
            } else {
                float pre[11];
#pragma unroll
                for (int k = 0; k < 11; ++k) pre[k] = bf2f(cur[k]);
                const float w0 = cw[ch], w1 = cw[3072 + ch], w2 = cw[6144 + ch], w3 = cw[9216 + ch], bias = cb[ch];
#pragma unroll
                for (int j = 0; j < 8; ++j) ov[j] = siluf_(bias + w0 * pre[j] + w1 * pre[j + 1] + w2 * pre[j + 2] + w3 * pre[j + 3]);
#pragma unroll
                for (int j = 0; j < 8; ++j) {
                    const int row = prow(b, tp0 + j); const bf16_t o = f2bf(ov[j]);
                    if (ch < 2048) XS[(size_t)row * 2048 + ch] = o;
                    else if (ch < 2560) BN[(size_t)row * 512 + ch - 2048] = o;
                    else CN[(size_t)row * 512 + ch - 2560] = o;
                }
            }
            const int c = tau8 >> 3, l0 = (tau8 & 7) * 8;
            u32x4 o; o.x = cvt_pk_bf16(ov[0], ov[1]); o.y = cvt_pk_bf16(ov[2], ov[3]); o.z = cvt_pk_bf16(ov[4], ov[5]); o.w = cvt_pk_bf16(ov[6], ov[7]);
            if (ch < 2048) { const int h = ch >> 6, pp = ch & 63; *(u32x4*)(XT + ((((size_t)(b * 33 + c) * 32 + h) * 64 + pp) * 64 + l0)) = o; }
            else if (ch < 2560) { const int g = (ch - 2048) >> 7, n = (ch - 2048) & 127; *(u32x4*)(BT + ((((size_t)(b * 33 + c) * 4 + g) * 128 + n) * 64 + l0)) = o; }
#pragma unroll
            for (int k = 0; k < 11; ++k) cur[k] = nxt[k];
        }
    }
#undef CONV_LOAD
    const float* sc = p->in[3];
    for (int it = gw; it < 128 * 48; it += nw) {
        const int cblk = it % 48, bs = it / 48, ch = cblk * 64 + lane, row = 8192 + bs;
        const float p0 = sc[(size_t)(bs * 3 + 0) * 3072 + ch], p1 = sc[(size_t)(bs * 3 + 1) * 3072 + ch], p2 = sc[(size_t)(bs * 3 + 2) * 3072 + ch];
        const float uu = bf2f(proj[(size_t)row * NPROJ + C_XBC + ch]);
        const float v = siluf_(cb[ch] + cw[ch] * p0 + cw[3072 + ch] * p1 + cw[6144 + ch] * p2 + cw[9216 + ch] * uu);
        const bf16_t o = f2bf(v);
        if (ch < 2048) XS[(size_t)row * 2048 + ch] = o;
        else if (ch < 2560) BN[(size_t)row * 512 + ch - 2048] = o;
        else CN[(size_t)row * 512 + ch - 2560] = o;
        float* oc = p->out + O_CONVS + (size_t)bs * 3 * 3072 + ch;
        oc[0] = p1; oc[3072] = p2; oc[6144] = uu;
    }
    const int gt = blockIdx.x * 512 + tid, ntt = gridDim.x * 512;
    for (int i = gt; i < 4 * 3 * 3072; i += ntt) {
        const int ch = i % 3072, k = (i / 3072) % 3, b = i / 9216;
        p->out[O_CONVP + i] = bf2f(proj[(size_t)prow(b, 2061 + k) * NPROJ + C_XBC + ch]);
    }
    float* DT = (float*)(p->ws + WS_DT); const float* dtb = p->in[11];
    for (int i = gt; i < 8336 * 32; i += ntt) DT[i] = softplusf_(DT[i] + dtb[i & 31]);
}

#define MFMA16(a, b, c) __builtin_amdgcn_mfma_f32_16x16x32_bf16((a), (b), (c), 0, 0, 0)

__device__ __forceinline__ void ssd_prompt_unit(PP p, LAS unsigned char* lds, int b, int h, const int tid) {
    const int wid = tid >> 6, lane = tid & 63, fr = lane & 15, fq = lane >> 4, g = h >> 3;
    LAS bf16_t* Cs = (LAS bf16_t*)(lds);
    LAS bf16_t* Bs = (LAS bf16_t*)(lds + 17408);
    LAS bf16_t* BTs = (LAS bf16_t*)(lds + 34816);
    LAS bf16_t* XTs = (LAS bf16_t*)(lds + 53248);
    LAS bf16_t* XTw = (LAS bf16_t*)(lds + 62464);
    LAS bf16_t* Ms = (LAS bf16_t*)(lds + 71680);
    LAS bf16_t* Hs = (LAS bf16_t*)(lds + 80896);
    LAS float* sm = (LAS float*)(lds + 98304);
    LAS bf16_t* Zs = (LAS bf16_t*)(lds + 100352);
    LAS bf16_t* Ys = (LAS bf16_t*)(lds + 109568);
    const bf16_t* proj = (const bf16_t*)(p->ws + WS_PROJ);
    const bf16_t* XT = (const bf16_t*)(p->ws + WS_R3); const bf16_t* BT = (const bf16_t*)(p->ws + WS_BT);
    const bf16_t* BN = (const bf16_t*)(p->ws + WS_BN); const bf16_t* CN = (const bf16_t*)(p->ws + WS_CN);
    const float* DT = (const float*)(p->ws + WS_DT);
    bf16_t* Y = (bf16_t*)(p->ws + WS_R1); float* GSQ = (float*)(p->ws + WS_GSQ);
    const float Ah = -expf(p->in[12][h]), Dh = p->in[13][h];
    for (int i = tid; i < 64 * 136 / 2; i += 512) ((LAS unsigned*)Hs)[i] = 0u;
    f32x4 Hacc[4];
#pragma unroll
    for (int t = 0; t < 4; ++t) Hacc[t] = (f32x4){0.f, 0.f, 0.f, 0.f};
    const int tr = wid >> 1, tb2 = (wid & 1) * 2, tb4 = (wid & 1) * 4;
    u32x4 gc[2], gb[2], gbt[2], gx, gz; float gdt;
#define SSD_ROW(c_, l_) ((c_) == 0 ? ((l_) >= 48 ? 8320 + (l_) - 48 : -1) : b * 2048 + ((c_) - 1) * 64 + (l_))
#define SSD_PREFETCH(c_) do { \
        { const int rl_ = SSD_ROW(c_, lane); gdt = rl_ >= 0 ? DT[(size_t)rl_ * 32 + h] : 0.f; } \
        _Pragma("unroll") for (int i_ = 0; i_ < 2; ++i_) { \
            const int e_ = tid + i_ * 512, row_ = e_ >> 4, v_ = e_ & 15; const int rg_ = SSD_ROW(c_, row_); \
            if (rg_ >= 0) { gc[i_] = *(const u32x4*)(CN + (size_t)rg_ * 512 + g * 128 + v_ * 8); gb[i_] = *(const u32x4*)(BN + (size_t)rg_ * 512 + g * 128 + v_ * 8); } \
            else { gc[i_] = (u32x4){0u, 0u, 0u, 0u}; gb[i_] = (u32x4){0u, 0u, 0u, 0u}; } \
            gbt[i_] = *(const u32x4*)(BT + (((size_t)(b * 33 + (c_)) * 4 + g) * 128) * 64 + (size_t)e_ * 8); } \
        gx = *(const u32x4*)(XT + ((((size_t)(b * 33 + (c_)) * 32 + h) * 64) * 64) + (size_t)tid * 8); \
        { const int rg_ = SSD_ROW(c_, tid >> 3); gz = rg_ >= 0 ? *(const u32x4*)(proj + (size_t)rg_ * NPROJ + C_ZA + 64 * h + (tid & 7) * 8) : (u32x4){0u, 0u, 0u, 0u}; } \
    } while (0)
    SSD_PREFETCH(0);
    for (int c = 0; c < 33; ++c) {
        const float dtv = gdt;
        float ac = dtv * Ah;
#pragma unroll
        for (int o = 1; o < 64; o <<= 1) { const float t = __shfl_up(ac, o); if (lane >= o) ac += t; }
        const float aend = __shfl(ac, 63);
        const float cdecay = __expf(aend);
        const float wl = dtv * __expf(aend - ac);
        if (wid == 0) { sm[lane] = dtv; sm[64 + lane] = ac; sm[192 + lane] = __expf(ac); }
#pragma unroll
        for (int i = 0; i < 2; ++i) {
            const int e = tid + i * 512;
            { const int row = e >> 4, v = e & 15; *(LAS u32x4*)(Cs + row * 136 + v * 8) = gc[i]; *(LAS u32x4*)(Bs + row * 136 + v * 8) = gb[i]; }
            { const int n = e >> 3, v = e & 7; *(LAS u32x4*)(BTs + n * 72 + v * 8) = gbt[i]; }
        }
        { const int pp = tid >> 3, v = tid & 7; *(LAS u32x4*)(XTs + pp * 72 + v * 8) = gx; *(LAS u32x4*)(Zs + pp * 72 + v * 8) = gz;
          float w8[8];
#pragma unroll
          for (int j = 0; j < 8; ++j) w8[j] = __shfl(wl, v * 8 + j);
          u32x4 xw;
          xw.x = cvt_pk_bf16(lo_bf(gx.x) * w8[0], hi_bf(gx.x) * w8[1]); xw.y = cvt_pk_bf16(lo_bf(gx.y) * w8[2], hi_bf(gx.y) * w8[3]);
          xw.z = cvt_pk_bf16(lo_bf(gx.z) * w8[4], hi_bf(gx.z) * w8[5]); xw.w = cvt_pk_bf16(lo_bf(gx.w) * w8[6], hi_bf(gx.w) * w8[7]);
          *(LAS u32x4*)(XTw + pp * 72 + v * 8) = xw; }
        if (c + 1 < 33) SSD_PREFETCH(c + 1);
        __syncthreads();
        {
            f32x4 cbm[2] = {(f32x4){0.f, 0.f, 0.f, 0.f}, (f32x4){0.f, 0.f, 0.f, 0.f}};
#pragma unroll
            for (int ks = 0; ks < 4; ++ks) {
                const bf16x8 a = *(const LAS bf16x8*)(Cs + (16 * tr + fr) * 136 + ks * 32 + fq * 8);
#pragma unroll
                for (int t = 0; t < 2; ++t) { const bf16x8 bb = *(const LAS bf16x8*)(Bs + (16 * (tb2 + t) + fr) * 136 + ks * 32 + fq * 8); cbm[t] = MFMA16(a, bb, cbm[t]); }
            }
#pragma unroll
            for (int t = 0; t < 2; ++t) {
                const int s_ = 16 * (tb2 + t) + fr; const float as = sm[64 + s_], ds = sm[s_];
#pragma unroll
                for (int i = 0; i < 4; ++i) { const int l = 16 * tr + 4 * fq + i; const float al = sm[64 + l];
                    const float v = (s_ <= l) ? cbm[t][i] * __expf(al - as) * ds : 0.f; Ms[l * 72 + s_] = f2bf(v); }
            }
        }
        __syncthreads();
        {
            f32x4 y[2] = {(f32x4){0.f, 0.f, 0.f, 0.f}, (f32x4){0.f, 0.f, 0.f, 0.f}};
#pragma unroll
            for (int ks = 0; ks < 4; ++ks) {
                const bf16x8 a = *(const LAS bf16x8*)(Cs + (16 * tr + fr) * 136 + ks * 32 + fq * 8);
#pragma unroll
                for (int t = 0; t < 2; ++t) { const bf16x8 bb = *(const LAS bf16x8*)(Hs + (16 * (tb2 + t) + fr) * 136 + ks * 32 + fq * 8); y[t] = MFMA16(a, bb, y[t]); }
            }
#pragma unroll
            for (int i = 0; i < 4; ++i) { const float e = sm[192 + 16 * tr + 4 * fq + i]; y[0][i] *= e; y[1][i] *= e; }
#pragma unroll
            for (int ks = 0; ks < 2; ++ks) {
                const bf16x8 a = *(const LAS bf16x8*)(Ms + (16 * tr + fr) * 72 + ks * 32 + fq * 8);
#pragma unroll
                for (int t = 0; t < 2; ++t) { const bf16x8 bb = *(const LAS bf16x8*)(XTs + (16 * (tb2 + t) + fr) * 72 + ks * 32 + fq * 8); y[t] = MFMA16(a, bb, y[t]); }
            }
#pragma unroll
            for (int i = 0; i < 4; ++i) {
                const int l = 16 * tr + 4 * fq + i;
                float sq = 0.f;
#pragma unroll
                for (int t = 0; t < 2; ++t) {
                    const int pc = 16 * (tb2 + t) + fr;
                    const float x = bf2f(XTs[pc * 72 + l]);
                    const float z = bf2f(Zs[l * 72 + pc]);
                    const float v = (y[t][i] + Dh * x) * z;
                    Ys[l * 72 + pc] = f2bf(v);
                    sq += v * v;
                }
                sq = red16_dpp(sq);
                if (fr == 0) sm[256 + l * 2 + (wid & 1)] = sq;
            }
        }
        {
#pragma unroll
            for (int t = 0; t < 4; ++t) Hacc[t] *= cdecay;
#pragma unroll
            for (int ks = 0; ks < 2; ++ks) {
                const bf16x8 a = *(const LAS bf16x8*)(XTw + (16 * tr + fr) * 72 + ks * 32 + fq * 8);
#pragma unroll
                for (int t = 0; t < 4; ++t) { const bf16x8 bb = *(const LAS bf16x8*)(BTs + (16 * (tb4 + t) + fr) * 72 + ks * 32 + fq * 8); Hacc[t] = MFMA16(a, bb, Hacc[t]); }
            }
        }
        __syncthreads();
#pragma unroll
        for (int t = 0; t < 4; ++t)
#pragma unroll
            for (int i = 0; i < 4; ++i) Hs[(16 * tr + 4 * fq + i) * 136 + 16 * (tb4 + t) + fr] = f2bf(Hacc[t][i]);
        { const int l = tid >> 3, v = tid & 7; const int rg = SSD_ROW(c, l);
          if (rg >= 0) *(u32x4*)(Y + (size_t)rg * 2048 + 64 * h + v * 8) = *(const LAS u32x4*)(Ys + l * 72 + v * 8);
          if (rg >= 0 && v == 0) GSQ[(size_t)rg * 32 + h] = sm[256 + l * 2] + sm[256 + l * 2 + 1]; }
    }
#undef SSD_PREFETCH
#undef SSD_ROW
    float* so = p->out + O_SSDP + ((size_t)(b * 32 + h) * 64) * 128;
#pragma unroll
    for (int t = 0; t < 4; ++t)
#pragma unroll
        for (int i = 0; i < 4; ++i) so[(size_t)(16 * tr + 4 * fq + i) * 128 + 16 * (tb4 + t) + fr] = Hacc[t][i];
    __syncthreads();
}

__device__ __forceinline__ void s5_unit(PP p, LAS unsigned char* lds, int b, int g, const int tid) {
    const int wid = tid >> 6, lane = tid & 63, fr = lane & 15, fq = lane >> 4;
    LAS float* coef = (LAS float*)lds;
    LAS float* table = (LAS float*)(lds + 2048);
    LAS float* wbuf = (LAS float*)(lds + 2048 + 66048 + wid * 8448);
    LAS bf16_t* wbh = (LAS bf16_t*)wbuf;
    const bf16_t* proj = (const bf16_t*)(p->ws + WS_PROJ);
    bf16_t* YB = (bf16_t*)(p->ws + WS_YB);
    const bool sample = (b == 4);
    if (wid == 0) {
        const int n = lane;
        const double step = d_exp((double)p->in[18][g]);
        const double lr = (double)p->in[16][g * 64 + n], li = (double)p->in[17][g * 64 + n];
        const double mag = d_exp(lr * step); double sn, cs; d_sincos(li * step, sn, cs);
        const double ar = mag * cs, ai = mag * sn;
        const double den = lr * lr + li * li, nr = ar - 1.0;
        const double cr = (nr * lr + ai * li) / den, ci = (ai * lr - nr * li) / den;
        double pr = ar, pi = ai;
#pragma unroll
        for (int q = 0; q < 4; ++q) { const double t = pr * pr - pi * pi; pi = 2.0 * pr * pi; pr = t; }
        coef[n * 8 + 0] = (float)ar; coef[n * 8 + 1] = (float)ai; coef[n * 8 + 2] = (float)cr; coef[n * 8 + 3] = (float)ci; coef[n * 8 + 4] = (float)pr; coef[n * 8 + 5] = (float)pi;
    }
    __syncthreads();
    bf16x8 Bf[8];
    {
        const float* bre = p->in[19]; const float* bim = p->in[20];
#pragma unroll
        for (int t8 = 0; t8 < 8; ++t8) {
            const int n = (16 * t8 + fr) & 63; const float cr = coef[n * 8 + 2], ci = coef[n * 8 + 3];
            u32x4 w = (u32x4){0u, 0u, 0u, 0u};
            if (fq < 2) {
                const f32x4 r0 = *(const f32x4*)(bre + (size_t)(g * 64 + n) * 16 + 8 * fq), r1 = *(const f32x4*)(bre + (size_t)(g * 64 + n) * 16 + 8 * fq + 4);
                const f32x4 i0 = *(const f32x4*)(bim + (size_t)(g * 64 + n) * 16 + 8 * fq), i1 = *(const f32x4*)(bim + (size_t)(g * 64 + n) * 16 + 8 * fq + 4);
                f32x4 v0, v1;
                if (t8 < 4) { v0 = cr * r0 - ci * i0; v1 = cr * r1 - ci * i1; } else { v0 = cr * i0 + ci * r0; v1 = cr * i1 + ci * r1; }
                w.x = cvt_pk_bf16(v0[0], v0[1]); w.y = cvt_pk_bf16(v0[2], v0[3]); w.z = cvt_pk_bf16(v1[0], v1[1]); w.w = cvt_pk_bf16(v1[2], v1[3]);
            }
            Bf[t8] = __builtin_bit_cast(bf16x8, w);
        }
    }
    bf16x8 Cf[4];
    {
        const float* cre = p->in[21]; const float* cim = p->in[22];
#pragma unroll
        for (int ks = 0; ks < 4; ++ks) {
            const float* src = (ks < 2 ? cre : cim) + (size_t)(g * 16 + fr) * 64 + 32 * (ks & 1) + 8 * fq;
            f32x4 v0 = *(const f32x4*)src, v1 = *(const f32x4*)(src + 4);
            if (ks >= 2) { v0 = -v0; v1 = -v1; }
            u32x4 w; w.x = cvt_pk_bf16(v0[0], v0[1]); w.y = cvt_pk_bf16(v0[2], v0[3]); w.z = cvt_pk_bf16(v1[0], v1[1]); w.w = cvt_pk_bf16(v1[2], v1[3]);
            Cf[ks] = __builtin_bit_cast(bf16x8, w);
        }
    }
    const float a_re = coef[lane * 8 + 0], a_im = coef[lane * 8 + 1];
    const float dsk = p->in[23][16 * g + fr];
    auto row_of = [&](int c, int t) -> int { return sample ? (8192 + 16 * c + t) : (c == 0 ? 8320 + t : b * 2048 + 16 * (c - 1) + t); };
    auto load_a = [&](int c) -> u32x4 {
        u32x4 a = (u32x4){0u, 0u, 0u, 0u};
        if (fq < 2) a = *(const u32x4*)(proj + (size_t)row_of(c, fr) * NPROJ + C_UB + 16 * g + 8 * fq);
        return a; };
    auto bu_tile = [&](const u32x4 a) {
        const bf16x8 af = __builtin_bit_cast(bf16x8, a);
#pragma unroll
        for (int t8 = 0; t8 < 8; ++t8) {
            const f32x4 r = MFMA16(af, Bf[t8], ((f32x4){0.f, 0.f, 0.f, 0.f}));
#pragma unroll
            for (int i = 0; i < 4; ++i) wbuf[(4 * fq + i) * 132 + 16 * t8 + fr] = r[i];
        }
    };
    if (!sample) {
        u32x4 a_nxt = load_a(wid);
        for (int c = wid; c < 129; c += 8) {
            const u32x4 a_cur = a_nxt; if (c + 8 < 129) a_nxt = load_a(c + 8);
            bu_tile(a_cur);
            float hr = 0.f, hi = 0.f;
#pragma unroll
            for (int t = 0; t < 16; ++t) { const float ur = wbuf[t * 132 + lane], ui = wbuf[t * 132 + 64 + lane];
                const float nr = a_re * hr - a_im * hi + ur; hi = a_re * hi + a_im * hr + ui; hr = nr; }
            table[c * 128 + lane] = hr; table[c * 128 + 64 + lane] = hi;
        }
        __syncthreads();
        if (wid == 0) {
            const float q_re = coef[lane * 8 + 4], q_im = coef[lane * 8 + 5];
            float hr = 0.f, hi = 0.f;
            for (int c = 0; c < 129; ++c) {
                const float lr = table[c * 128 + lane], li = table[c * 128 + 64 + lane];
                table[c * 128 + lane] = hr; table[c * 128 + 64 + lane] = hi;
                const float nr = q_re * hr - q_im * hi + lr; hi = q_re * hi + q_im * hr + li; hr = nr;
            }
            p->out[O_S5RP + (size_t)(b * 64 + g) * 64 + lane] = hr;
            p->out[O_S5IP + (size_t)(b * 64 + g) * 64 + lane] = hi;
        }
        __syncthreads();
    }
    const int cend = sample ? 8 : 129;
    u32x4 a_nxt2 = load_a(wid);
    for (int c = wid; c < cend; c += 8) {
        const u32x4 a_cur = a_nxt2; if (c + 8 < cend) a_nxt2 = load_a(c + 8);
        bu_tile(a_cur);
        if (!sample) {
            float hr = table[c * 128 + lane], hi = table[c * 128 + 64 + lane];
#pragma unroll
            for (int t = 0; t < 16; ++t) { const float ur = wbuf[t * 132 + lane], ui = wbuf[t * 132 + 64 + lane];
                const float nr = a_re * hr - a_im * hi + ur; hi = a_re * hi + a_im * hr + ui; hr = nr;
                wbh[t * 264 + lane] = f2bf(hr); wbh[t * 264 + 64 + lane] = f2bf(hi); }
        } else {
            const float* s_re = p->in[4]; const float* s_im = p->in[5];
#pragma unroll
            for (int t = 0; t < 16; ++t) { const int bs = 16 * c + t; const size_t si = (size_t)(bs * 64 + g) * 64 + lane;
                const float h0r = s_re[si], h0i = s_im[si];
                const float ur = wbuf[t * 132 + lane], ui = wbuf[t * 132 + 64 + lane];
                const float hr = a_re * h0r - a_im * h0i + ur, hi = a_re * h0i + a_im * h0r + ui;
                p->out[O_S5RS + si] = hr; p->out[O_S5IS + si] = hi;
                wbh[t * 264 + lane] = f2bf(hr); wbh[t * 264 + 64 + lane] = f2bf(hi); }
        }
        if (fq < 2) *(LAS u32x4*)(wbh + fr * 264 + 128 + 8 * fq) = a_cur;
        f32x4 y = (f32x4){0.f, 0.f, 0.f, 0.f};
#pragma unroll
        for (int ks = 0; ks < 4; ++ks) { const bf16x8 af = *(const LAS bf16x8*)(wbh + fr * 264 + 32 * ks + 8 * fq); y = MFMA16(af, Cf[ks], y); }
#pragma unroll
        for (int i = 0; i < 4; ++i) {
            const int row = row_of(c, 4 * fq + i);
            const float uu = bf2f(wbh[(4 * fq + i) * 264 + 128 + fr]);
            YB[(size_t)row * 1024 + 16 * g + fr] = f2bf(gelu_tanh(y[i] + dsk * uu));
        }
    }
    __syncthreads();
}

__device__ __forceinline__ void ssd_sample_unit(PP p, LAS unsigned char* lds, int bs, int g, const int tid) {
    const int n4 = tid & 31, row = 8192 + bs, p0 = tid >> 5;
    LAS float* ybuf = (LAS float*)lds;
    LAS float* red = ybuf + 512;
    LAS float* xsf = ybuf + 544;
    LAS float* zsf = ybuf + 1056;
    LAS float* hsc = ybuf + 1568;
    const bf16_t* proj = (const bf16_t*)(p->ws + WS_PROJ);
    const bf16_t* XS = (const bf16_t*)(p->ws + WS_R2);
    const bf16_t* BN = (const bf16_t*)(p->ws + WS_BN); const bf16_t* CN = (const bf16_t*)(p->ws + WS_CN);
    const float* DT = (const float*)(p->ws + WS_DT);
    bf16_t* Y = (bf16_t*)(p->ws + WS_R1); float* GSQ = (float*)(p->ws + WS_GSQ);
    const float* s0 = p->in[2] + ((size_t)(bs * 32 + 8 * g) * 64 + p0) * 128 + 4 * n4;
    float* s1 = p->out + O_SSDS + ((size_t)(bs * 32 + 8 * g) * 64 + p0) * 128 + 4 * n4;
    f32x4 cur[8], nxt[8];
#pragma unroll
    for (int j = 0; j < 8; ++j) cur[j] = *(const f32x4*)(s0 + (size_t)(j >> 2) * 8192 + (size_t)(j & 3) * 2048);
    xsf[tid] = bf2f(XS[(size_t)row * 2048 + 512 * g + tid]);
    zsf[tid] = bf2f(proj[(size_t)row * NPROJ + C_ZA + 512 * g + tid]);
    if (tid < 8) { const int h = 8 * g + tid; const float dt = DT[(size_t)row * 32 + h]; hsc[tid * 4] = dt; hsc[tid * 4 + 1] = __expf(-dt * expf(p->in[12][h])); hsc[tid * 4 + 2] = p->in[13][h]; }
    const u32x2 bw = *(const u32x2*)(BN + (size_t)row * 512 + g * 128 + 4 * n4), cw = *(const u32x2*)(CN + (size_t)row * 512 + g * 128 + 4 * n4);
    const f32x4 Bv = (f32x4){lo_bf(bw.x), hi_bf(bw.x), lo_bf(bw.y), hi_bf(bw.y)}, Cv = (f32x4){lo_bf(cw.x), hi_bf(cw.x), lo_bf(cw.y), hi_bf(cw.y)};
    __syncthreads();
#pragma unroll
    for (int hp = 0; hp < 4; ++hp) {
        if (hp < 3) {
#pragma unroll
            for (int j = 0; j < 8; ++j) nxt[j] = *(const f32x4*)(s0 + (size_t)(2 * hp + 2 + (j >> 2)) * 8192 + (size_t)(j & 3) * 2048);
        }
#pragma unroll
        for (int j = 0; j < 8; ++j) {
            const int hh = 2 * hp + (j >> 2), pp = p0 + 16 * (j & 3);
            const float dt = hsc[hh * 4], dA = hsc[hh * 4 + 1], Dh = hsc[hh * 4 + 2];
            const float x = xsf[hh * 64 + pp], dtx = dt * x;
            const f32x4 hn = dA * cur[j] + dtx * Bv;
            *(f32x4*)(s1 + (size_t)hh * 8192 + (size_t)(j & 3) * 2048) = hn;
            float part = Cv[0] * hn[0] + Cv[1] * hn[1] + Cv[2] * hn[2] + Cv[3] * hn[3];
            part = red16_dpp(part); part += __shfl_xor(part, 16);
            if (n4 == 0) ybuf[hh * 64 + pp] = (part + Dh * x) * zsf[hh * 64 + pp];
        }
        if (hp < 3) {
#pragma unroll
            for (int j = 0; j < 8; ++j) cur[j] = nxt[j];
        }
    }
    __syncthreads();
    const float v = ybuf[tid];
    Y[(size_t)row * 2048 + 512 * g + tid] = f2bf(v);
    float sq = v * v;
#pragma unroll
    for (int o = 32; o >= 1; o >>= 1) sq += __shfl_xor(sq, o);
    if ((tid & 63) == 0) red[tid >> 6] = sq;
    __syncthreads();
    if (tid < 8) { float t = 0.f; if (tid == 0) for (int i = 0; i < 8; ++i) t += red[i]; GSQ[(size_t)row * 32 + 8 * g + tid] = t; }
    __syncthreads();
}

__device__ __forceinline__ void phase3(PP p, LAS unsigned char* lds, const int it_lo = 0, const int it_hi = 960) {
    LAS int* qslot = (LAS int*)(lds + LDS_BYTES - 16);
    unsigned* ctr = (unsigned*)(p->ws + WS_CTL);
    for (;;) {
        __syncthreads();
        if (threadIdx.x == 0) *qslot = (int)atomicAdd(ctr, 1u);
        __syncthreads();
        const int it = __builtin_amdgcn_readfirstlane(*qslot) + it_lo;
        if (it >= it_hi) break;
        int tid = threadIdx.x; asm volatile("" : "+v"(tid));
        if (it < 128) ssd_prompt_unit(p, lds, it >> 5, it & 31, tid);
        else if (it < 384) s5_unit(p, lds, (it - 128) >> 6, (it - 128) & 63, tid);
        else if (it < 448) s5_unit(p, lds, 4, it - 384, tid);
        else ssd_sample_unit(p, lds, (it - 448) >> 2, (it - 448) & 3, tid);
    }
}

__device__ __forceinline__ void skinny_kloop(const bf16_t* A, int lda, const bf16_t* Bt, int K, int row0, int col0, int wid, int fr, int fq, f32x4 (&ac)[4]) {
    const int nks = K / 256;
    const bf16_t* ap = A + (size_t)(row0 + fr) * lda + wid * (K / 8) + 8 * fq;
    const bf16_t* bp = Bt + (size_t)(col0 + fr) * K + wid * (K / 8) + 8 * fq;
    for (int ks = 0; ks < nks; ks += 4) {
        bf16x8 a[4], b[4][4];
#pragma unroll
        for (int j = 0; j < 4; ++j) {
            a[j] = *(const bf16x8*)(ap + (ks + j) * 32);
#pragma unroll
            for (int t = 0; t < 4; ++t) b[j][t] = *(const bf16x8*)(bp + (size_t)t * 16 * K + (ks + j) * 32);
        }
#pragma unroll
        for (int j = 0; j < 4; ++j)
#pragma unroll
            for (int t = 0; t < 4; ++t) ac[t] = MFMA16(a[j], b[j][t], ac[t]);
    }
}
template <int MODE>
__device__ __forceinline__ void skinny_job(PP p, LAS unsigned char* lds, int job, const int tid) {
    const int wid = tid >> 6, lane = tid & 63, fr = lane & 15, fq = lane >> 4;
    const int rt = job & 7, cg = job >> 3, row0 = 8192 + 16 * rt, col0 = 64 * cg;
    const bf16_t* PROJ = (const bf16_t*)(p->ws + WS_PROJ);
    LAS f32x4* red = (LAS f32x4*)lds;
    LAS f32x4* red2 = red + 2048;
    LAS float* rs = (LAS float*)(lds + 65536);
    f32x4 ac[4], ac2[4];
#pragma unroll
    for (int t = 0; t < 4; ++t) { ac[t] = (f32x4){0.f, 0.f, 0.f, 0.f}; ac2[t] = (f32x4){0.f, 0.f, 0.f, 0.f}; }
    if (MODE == 0) skinny_kloop((const bf16_t*)(p->ws + WS_YB), 1024, (const bf16_t*)(p->ws + WS_WTGLU), 1024, row0, col0, wid, fr, fq, ac);
    if (MODE == 1) { skinny_kloop((const bf16_t*)(p->ws + WS_R1), 2048, (const bf16_t*)(p->ws + WS_WTA), 2048, row0, col0, wid, fr, fq, ac);
                     skinny_kloop((const bf16_t*)(p->ws + WS_YB2), 1024, (const bf16_t*)(p->ws + WS_WTB), 1024, row0, col0, wid, fr, fq, ac2); }
    if (MODE == 2) skinny_kloop((const bf16_t*)(p->ws + WS_R2), 2048, (const bf16_t*)(p->ws + WS_WTOUT), 2048, row0, col0, wid, fr, fq, ac);
#pragma unroll
    for (int t = 0; t < 4; ++t) { red[(wid * 4 + t) * 64 + lane] = ac[t]; if (MODE == 1) red2[(wid * 4 + t) * 64 + lane] = ac2[t]; }
    __syncthreads();
    const int t = wid & 3, half = wid >> 2;
    float v[2] = {0.f, 0.f}, v2[2] = {0.f, 0.f};
#pragma unroll
    for (int w2 = 0; w2 < 8; ++w2) {
        const f32x4 q = red[(w2 * 4 + t) * 64 + lane]; v[0] += q[2 * half]; v[1] += q[2 * half + 1];
        if (MODE == 1) { const f32x4 q2 = red2[(w2 * 4 + t) * 64 + lane]; v2[0] += q2[2 * half]; v2[1] += q2[2 * half + 1]; }
    }
    const int col = col0 + 16 * t + fr;
#pragma unroll
    for (int e = 0; e < 2; ++e) {
        const int rl = 4 * fq + 2 * half + e, row = row0 + rl;
        if (MODE == 0) {
            const float yb = bf2f(((const bf16_t*)(p->ws + WS_YB))[(size_t)row * 1024 + col]), zb = bf2f(PROJ[(size_t)row * NPROJ + C_ZB + col]);
            ((bf16_t*)(p->ws + WS_YB2))[(size_t)row * 1024 + col] = f2bf(yb * sigmoidf_(v[e] + p->in[25][col]) * zb);
        } else if (MODE == 1) {
            const float ga = bf2f(PROJ[(size_t)row * NPROJ + C_GA + col]), gb = bf2f(PROJ[(size_t)row * NPROJ + C_GB + col]);
            ((bf16_t*)(p->ws + WS_R2))[(size_t)row * 2048 + col] = f2bf(ga * v[e] + gb * v2[e]);
        } else {
            const float o = p->in[1][(size_t)(row - 8192) * 2048 + col] + v[e];
            p->out[(size_t)row * 2048 + col] = o;
            const float sq = red16_dpp(o * o);
            if (fr == 0) rs[rl * 4 + t] = sq;
        }
    }
    __syncthreads();
    if (MODE == 2 && tid < 16) ((float*)(p->ws + WS_ROWSQ))[(size_t)(row0 + tid) * 32 + cg] = (rs[tid * 4] + rs[tid * 4 + 1]) + (rs[tid * 4 + 2] + rs[tid * 4 + 3]);
}

__device__ __forceinline__ void ynorm_fix(PP p, LAS unsigned char* lds, const int tid) {
    const int wid = tid >> 6, lane = tid & 63;
    LAS int* qslot = (LAS int*)(lds + LDS_BYTES - 16);
    unsigned* ctr = (unsigned*)(p->ws + WS_CTL) + 1;
    bf16_t* Y = (bf16_t*)(p->ws + WS_R1); const float* GSQ = (const float*)(p->ws + WS_GSQ); const float* nw = p->in[14];
    for (;;) {
        __syncthreads();
        if (tid == 0) *qslot = (int)atomicAdd(ctr, 1u);
        __syncthreads();
        const int it = *qslot;
        if (it >= 1040) break;
        const int r = it * 8 + wid;
#pragma unroll
        for (int i = 0; i < 4; ++i) {
            const f32x4 q0 = *(const f32x4*)(GSQ + (size_t)r * 32 + 8 * i), q1 = *(const f32x4*)(GSQ + (size_t)r * 32 + 8 * i + 4);
            const float rs = rsqrtf(((q0[0] + q0[1]) + (q0[2] + q0[3]) + (q1[0] + q1[1]) + (q1[2] + q1[3])) * (1.0f / 512.0f) + 1e-5f);
            u32x4* ptr = (u32x4*)(Y + (size_t)r * 2048) + i * 64 + lane;
            const u32x4 v = *ptr;
            const f32x4 w0 = *(const f32x4*)(nw + (i * 64 + lane) * 8), w1 = *(const f32x4*)(nw + (i * 64 + lane) * 8 + 4);
            u32x4 o;
            o.x = cvt_pk_bf16(lo_bf(v.x) * rs * w0[0], hi_bf(v.x) * rs * w0[1]); o.y = cvt_pk_bf16(lo_bf(v.y) * rs * w0[2], hi_bf(v.y) * rs * w0[3]);
            o.z = cvt_pk_bf16(lo_bf(v.z) * rs * w1[0], hi_bf(v.z) * rs * w1[1]); o.w = cvt_pk_bf16(lo_bf(v.w) * rs * w1[2], hi_bf(v.w) * rs * w1[3]);
            *ptr = o;
        }
    }
}

__device__ __forceinline__ void phase7(PP p, const int tid) {
    const int wid = tid >> 6, lane = tid & 63;
    const float* rowsq = (const float*)(p->ws + WS_ROWSQ); const float* fw = p->in[28];
    for (int r = blockIdx.x * 8 + wid; r < 8320; r += gridDim.x * 8) {
        float ssq = lane < 32 ? rowsq[(size_t)r * 32 + lane] : 0.f;
#pragma unroll
        for (int o = 16; o >= 1; o >>= 1) ssq += __shfl_xor(ssq, o);
        ssq = __shfl(ssq, 0);
        const float rs = rsqrtf(ssq * (1.0f / 2048.0f) + 1e-5f);
        f32x4* ptr = (f32x4*)(p->out + (size_t)r * 2048);
#pragma unroll
        for (int i = 0; i < 8; ++i) { const f32x4 w = ((const f32x4*)fw)[i * 64 + lane]; f32x4 v = ptr[i * 64 + lane]; v = v * rs * w; ptr[i * 64 + lane] = v; }
    }
}

__global__ void __launch_bounds__(512) mk_fwd(Params pa, int ph_lo, int ph_hi) {
    extern __shared__ __attribute__((aligned(16))) unsigned char smem[];
    LAS unsigned char* lds = (LAS unsigned char*)smem;
    cg::grid_group grid = cg::this_grid();
#define PH_BEGIN(k) if (ph_lo <= (k) && (k) < ph_hi) { if (ph_lo < (k)) grid.sync();
#define PH_ENV PP p = (PP)__builtin_amdgcn_kernarg_segment_ptr(); asm volatile("" : "+s"(p)); int tid = threadIdx.x; asm volatile("" : "+v"(tid)); \
        const bf16_t* PROJ = (const bf16_t*)(p->ws + WS_PROJ); (void)PROJ;
#define PH_END }
#define BODY0 { PH_ENV phase0(p, lds, tid); }
#define BODY1 { PH_ENV \
        pg8::Gemm g{(const bf16_t*)(p->ws + WS_R1), (const bf16_t*)(p->ws + WS_WTIN), MP, NPROJ, 2048}; \
        pg8::StaticOrder S; S.init(MP, NPROJ, gridDim.x, blockIdx.x); \
        EpiProj E{(bf16_t*)(p->ws + WS_PROJ), (float*)(p->ws + WS_DT)}; \
        pg8::gemm_phase(lds, g, S, E, tid); }
#define BODY2 { PH_ENV phase2(p, tid); }
#define BODY3 { PH_ENV phase3(p, lds); }
#define BODY4 { PH_ENV \
        pg8::Gemm g{(const bf16_t*)(p->ws + WS_YB), (const bf16_t*)(p->ws + WS_WTGLU), 8192, 1024, 1024}; \
        pg8::StaticOrder S; S.init(8192, 1024, gridDim.x, blockIdx.x); \
        EpiGlu E{(const bf16_t*)(p->ws + WS_YB), PROJ, p->in[25], (bf16_t*)(p->ws + WS_YB2)}; \
        pg8::gemm_phase(lds, g, S, E, tid); \
        for (int job = (int)((blockIdx.x + gridDim.x / 2) % gridDim.x); job < 128; job += gridDim.x) skinny_job<0>(p, lds, job, tid); \
        ynorm_fix(p, lds, tid); }
#define BODY5 { PH_ENV \
        pg8::StaticOrder S; S.init(8192, 2048, gridDim.x, blockIdx.x); \
        { pg8::Gemm g{(const bf16_t*)(p->ws + WS_R1), (const bf16_t*)(p->ws + WS_WTA), 8192, 2048, 2048}; \
          EpiMix<0> E{PROJ, nullptr, (bf16_t*)(p->ws + WS_R3)}; \
          pg8::gemm_phase(lds, g, S, E, tid); } \
        { pg8::Gemm g{(const bf16_t*)(p->ws + WS_YB2), (const bf16_t*)(p->ws + WS_WTB), 8192, 2048, 1024}; \
          EpiMix<1> E{PROJ, (const bf16_t*)(p->ws + WS_R3), (bf16_t*)(p->ws + WS_R2)}; \
          pg8::gemm_phase(lds, g, S, E, tid); } \
        for (int job = blockIdx.x; job < 256; job += gridDim.x) skinny_job<1>(p, lds, job, tid); }
#define BODY6 { PH_ENV \
        pg8::Gemm g{(const bf16_t*)(p->ws + WS_R2), (const bf16_t*)(p->ws + WS_WTOUT), 8192, 2048, 2048}; \
        pg8::StaticOrder S; S.init(8192, 2048, gridDim.x, blockIdx.x); \
        EpiOut E{p->in[0], p->in[1], p->out, (float*)(p->ws + WS_ROWSQ)}; \
        pg8::gemm_phase(lds, g, S, E, tid); \
        for (int job = blockIdx.x; job < 256; job += gridDim.x) skinny_job<2>(p, lds, job, tid); }
#define BODY7 { PH_ENV phase7(p, tid); }
    PH_BEGIN(0) BODY0 PH_END
#if DUP_PH == 0
    grid.sync(); BODY0
#endif
    PH_BEGIN(1) BODY1 PH_END
#if DUP_PH == 1
    grid.sync(); BODY1
#endif
    PH_BEGIN(2) BODY2 PH_END
    PH_BEGIN(3) BODY3 PH_END
#if DUP_PH == 3
    grid.sync();
    { if (blockIdx.x == 0 && threadIdx.x == 0) *(unsigned*)(pa.ws + WS_CTL) = 0u; }
    grid.sync(); { PH_ENV phase3(p, lds, DUP_LO, DUP_HI); }
#endif
    PH_BEGIN(4) BODY4 PH_END
    PH_BEGIN(5) BODY5 PH_END
#if DUP_PH == 5
    grid.sync(); BODY5
#endif
    PH_BEGIN(6) BODY6 PH_END
    PH_BEGIN(7) BODY7 PH_END
}

extern "C" void kernel_launch(void* const* d_in, const int* in_sizes, int n_in, void* d_out, int out_size, void* d_ws, size_t ws_size, hipStream_t stream) {
    static int grid_blocks = 0;
    if (grid_blocks == 0) {
        if (n_in != 29 || ws_size < WS_END) { fprintf(stderr, "kernel_launch: unexpected n_in %d or ws_size %zu (< %zu)\n", n_in, ws_size, (size_t)WS_END); grid_blocks = -1; return; }
        int dev = 0, cus = 0, per_cu = 0;
        hipGetDevice(&dev);
        hipDeviceGetAttribute(&cus, hipDeviceAttributeMultiprocessorCount, dev);
        if (hipFuncSetAttribute((const void*)mk_fwd, hipFuncAttributeMaxDynamicSharedMemorySize, LDS_BYTES) != hipSuccess) { fprintf(stderr, "kernel_launch: hipFuncSetAttribute failed\n"); grid_blocks = -1; return; }
        if (hipOccupancyMaxActiveBlocksPerMultiprocessor(&per_cu, (const void*)mk_fwd, 512, LDS_BYTES) != hipSuccess || per_cu < 1) { fprintf(stderr, "kernel_launch: occupancy query gave %d\n", per_cu); per_cu = 1; (void)hipGetLastError(); }
        grid_blocks = cus * per_cu;
    }
    if (grid_blocks < 0) return;
    Params p{};
    for (int i = 0; i < 29; ++i) p.in[i] = (const float*)d_in[i];
    p.out = (float*)d_out; p.ws = (unsigned char*)d_ws;
#if ONE_LAUNCH
    int lo = 0, hi = 8;
    void* args[] = {&p, &lo, &hi};
    hipError_t e = hipLaunchCooperativeKernel((const void*)mk_fwd, dim3(grid_blocks), dim3(512), args, LDS_BYTES, stream);
    if (e != hipSuccess) fprintf(stderr, "cooperative launch failed: %s (grid %d)\n", hipGetErrorString(e), grid_blocks);
#else
    for (int ph = 0; ph < 8; ++ph) hipLaunchKernelGGL(mk_fwd, dim3(grid_blocks), dim3(512), LDS_BYTES, stream, p, ph, ph + 1);
#endif
}
```

```cpp
#include <hip/hip_runtime.h>
#include <hip/hip_cooperative_groups.h>
#include <cstdio>
namespace cg = cooperative_groups;

#define DUP_PH -1
#define DUP_LO 0
#define DUP_HI 960
#ifndef ONE_LAUNCH
#define ONE_LAUNCH 1
#endif

#define LAS __attribute__((address_space(3)))
typedef unsigned short bf16_t;
typedef short bf16x8 __attribute__((ext_vector_type(8)));
typedef float f32x4 __attribute__((ext_vector_type(4)));
typedef float f32x2 __attribute__((ext_vector_type(2)));
typedef unsigned u32x4 __attribute__((ext_vector_type(4)));
typedef unsigned u32x2 __attribute__((ext_vector_type(2)));

constexpr int MP = 8448;
constexpr int NPROJ = 11520;
constexpr int C_ZA = 0, C_XBC = 2048, C_UB = 5120, C_ZB = 6144, C_GA = 7168, C_GB = 9216, C_DT = 11264;
constexpr int LDS_BYTES = 139264;

constexpr size_t O_YP = 0, O_YS = 16777216, O_SSDP = 17039360, O_CONVP = 18087936, O_S5RP = 18124800, O_S5IP = 18141184,
                 O_SSDS = 18157568, O_CONVS = 51712000, O_S5RS = 52891648, O_S5IS = 53415936;

constexpr size_t WS_CTL = 0;
constexpr size_t WS_ROWSQ = 4096;
constexpr size_t WS_GSQ = WS_ROWSQ + (size_t)MP * 32 * 4;
constexpr size_t WS_DT = WS_GSQ + (size_t)MP * 32 * 4;
constexpr size_t WS_DTS = WS_DT + 1081344;
constexpr size_t WS_WTIN = WS_DTS + 1081344;
constexpr size_t WS_WTA = WS_WTIN + (size_t)NPROJ * 2048 * 2;
constexpr size_t WS_WTGLU = WS_WTA + (size_t)2048 * 2048 * 2;
constexpr size_t WS_WTB = WS_WTGLU + (size_t)1024 * 1024 * 2;
constexpr size_t WS_WTOUT = WS_WTB + (size_t)2048 * 1024 * 2;
constexpr size_t WS_R1 = WS_WTOUT + (size_t)2048 * 2048 * 2;
constexpr size_t WS_R2 = WS_R1 + (size_t)MP * 2048 * 2;
constexpr size_t WS_R3 = WS_R2 + (size_t)MP * 2048 * 2;
constexpr size_t WS_PROJ = WS_R3 + (size_t)MP * 2048 * 2;
constexpr size_t WS_BN = WS_PROJ + (size_t)MP * NPROJ * 2;
constexpr size_t WS_CN = WS_BN + (size_t)MP * 512 * 2;
constexpr size_t WS_BT = WS_CN + (size_t)MP * 512 * 2;
constexpr size_t WS_YB = WS_BT + (size_t)MP * 512 * 2;
constexpr size_t WS_YB2 = WS_YB + (size_t)MP * 1024 * 2;
constexpr size_t WS_END = WS_YB2 + (size_t)MP * 1024 * 2;

struct Params {
    const float* in[29];
    float* out;
    unsigned char* ws;
};
typedef const __attribute__((address_space(4))) Params* PP;

__device__ __forceinline__ float bf2f(bf16_t b) { return __uint_as_float(((unsigned)b) << 16); }
__device__ __forceinline__ bf16_t f2bf(float f) { unsigned u = __float_as_uint(f); u += 0x7FFFu + ((u >> 16) & 1u); return (bf16_t)(u >> 16); }
__device__ __forceinline__ unsigned cvt_pk_bf16(float lo, float hi) { unsigned r; asm volatile("v_cvt_pk_bf16_f32 %0, %1, %2" : "=v"(r) : "v"(lo), "v"(hi)); return r; }
__device__ __forceinline__ float lo_bf(unsigned w) { return __uint_as_float(w << 16); }
__device__ __forceinline__ float hi_bf(unsigned w) { return __uint_as_float(w & 0xffff0000u); }
__device__ __forceinline__ float sigmoidf_(float x) { return __builtin_amdgcn_rcpf(1.0f + __expf(-x)); }
__device__ __forceinline__ float siluf_(float x) { return x * sigmoidf_(x); }
__device__ __forceinline__ float gelu_tanh(float x) {
    const float u = 0.7978845608028654f * (x + 0.044715f * x * x * x);
    const float e = __expf(2.0f * u);
    const float t = 1.0f - 2.0f * __builtin_amdgcn_rcpf(1.0f + e);
    return 0.5f * x * (1.0f + t);
}
__device__ __forceinline__ float softplusf_(float x) { return fmaxf(x, 0.0f) + log1pf(__expf(-fabsf(x))); }
__device__ __forceinline__ int prow(int b, int tp) { return tp < 16 ? (8320 + tp) : (b * 2048 + tp - 16); }

__device__ __forceinline__ float red16_dpp(float v) {
    v += __int_as_float(__builtin_amdgcn_update_dpp(0, __float_as_int(v), 0xB1, 0xF, 0xF, true));
    v += __int_as_float(__builtin_amdgcn_update_dpp(0, __float_as_int(v), 0x4E, 0xF, 0xF, true));
    v += __int_as_float(__builtin_amdgcn_update_dpp(0, __float_as_int(v), 0x141, 0xF, 0xF, true));
    v += __int_as_float(__builtin_amdgcn_update_dpp(0, __float_as_int(v), 0x140, 0xF, 0xF, true));
    return v;
}

__device__ __forceinline__ double d_exp(double x) {
    const double kf = __builtin_rint(x * 1.4426950408889634);
    const double r = (x - kf * 0.693147180369123816490e+00) - kf * 1.90821492927058770002e-10;
    double s = 1.0 / 6227020800.0;
    s = s * r + 1.0 / 479001600.0;
    s = s * r + 1.0 / 39916800.0;
    s = s * r + 1.0 / 3628800.0;
    s = s * r + 1.0 / 362880.0;
    s = s * r + 1.0 / 40320.0;
    s = s * r + 1.0 / 5040.0;
    s = s * r + 1.0 / 720.0;
    s = s * r + 1.0 / 120.0;
    s = s * r + 1.0 / 24.0;
    s = s * r + 1.0 / 6.0;
    s = s * r + 0.5;
    s = s * r + 1.0;
    s = s * r + 1.0;
    const long long bits = ((long long)((int)kf + 1023)) << 52;
    return s * __longlong_as_double(bits);
}
__device__ __forceinline__ void d_sincos(double x, double& sn, double& cs) {
    const double kf = __builtin_rint(x * 0.63661977236758134308);
    const double y = (x - kf * 1.57079632673412561417e+00) - kf * 6.07710050650619224932e-11;
    const double y2 = y * y;
    double ps = -1.0 / 1307674368000.0;
    ps = ps * y2 + 1.0 / 6227020800.0;
    ps = ps * y2 - 1.0 / 39916800.0;
    ps = ps * y2 + 1.0 / 362880.0;
    ps = ps * y2 - 1.0 / 5040.0;
    ps = ps * y2 + 1.0 / 120.0;
    ps = ps * y2 - 1.0 / 6.0;
    ps = ps * y2 + 1.0;
    const double s0 = y * ps;
    double pc = 1.0 / 20922789888000.0;
    pc = pc * y2 - 1.0 / 87178291200.0;
    pc = pc * y2 + 1.0 / 479001600.0;
    pc = pc * y2 - 1.0 / 3628800.0;
    pc = pc * y2 + 1.0 / 40320.0;
    pc = pc * y2 - 1.0 / 720.0;
    pc = pc * y2 + 1.0 / 24.0;
    pc = pc * y2 - 0.5;
    pc = pc * y2 + 1.0;
    const int q = ((int)kf) & 3;
    sn = (q == 0) ? s0 : (q == 1) ? pc : (q == 2) ? -s0 : -pc;
    cs = (q == 0) ? pc : (q == 1) ? -s0 : (q == 2) ? -pc : s0;
}

namespace pg8 {
constexpr int BM = 256, BK = 64, HALF = 128, HTB = HALF * BK * 2, STAGE_BYTES = 8 * HTB, NXCD = 8, WGM = 8;
__device__ __forceinline__ int lds_byte(int r, int c) { const int st = (r >> 4) * 2 + (c >> 5), rr = r & 15, cc = c & 31, ob = rr * 64 + cc * 2; return st * 1024 + (ob ^ (((ob >> 9) & 1) << 5)); }
__device__ __forceinline__ void stage_rc(int b, int& R, int& C) { const int st = b / 1024, sb = b % 1024, swz = sb ^ (((sb >> 9) & 1) << 5); R = (st >> 1) * 16 + swz / 64; C = (st & 1) * 32 + (swz % 64) / 2; }
__device__ __forceinline__ int perm32(int rho) { const int n = rho >> 4, i = rho & 15; return 8 * (i >> 2) + 4 * n + (i & 3); }
struct Unit { int pm, pn; };
struct Gemm { const bf16_t* A; const bf16_t* Bt; int M, N, K; };
struct StaticOrder {
    int nM, nN, nwg, G, c;
    __device__ void init(int M, int N, int G_, int c_) { nM = M / BM; nN = N / BM; nwg = nM * nN; G = G_; c = c_; }
    __device__ bool next(int i, Unit& u) const {
        const long L = (long)i * G + c; if (L >= nwg) return false;
        int wgid = (int)L; { const int q = nwg / NXCD, r = nwg % NXCD, xcd = wgid % NXCD, off = wgid / NXCD; wgid = (xcd < r ? xcd * (q + 1) : r * (q + 1) + (xcd - r) * q) + off; }
        const int nig = WGM * nN, gid = wgid / nig, fm = gid * WGM, gsz = (nM - fm) < WGM ? (nM - fm) : WGM;
        u.pm = fm + ((wgid % nig) % gsz); u.pn = (wgid % nig) / gsz; return true;
    }
};
template <class Epi, class Sched>
__device__ __forceinline__ void gemm_phase(LAS unsigned char* lds, const Gemm g, const Sched& S, const Epi& E, const int tid) {
    const int wid = __builtin_amdgcn_readfirstlane(tid >> 6), lane = tid & 63, wr = wid >> 2, wc = wid & 3, fr = lane & 15, fq = lane >> 4;
    const int K = g.K, nt = K / BK;
    unsigned voffA[2], voffB[2];
#pragma unroll
    for (int i = 0; i < 2; ++i) { int R, C; stage_rc(tid * 16 + i * 8192, R, C); const int Rb = Epi::PERM ? ((R & ~31) + perm32(R & 31)) : R;
        voffA[i] = (unsigned)(R * K + C) * 2u; voffB[i] = (unsigned)(Rb * K + C) * 2u; }
    const size_t kstep = (size_t)(BK * 2);
    const size_t hstep = (size_t)HALF * K * 2;
    const size_t tstep = 2 * hstep;
    const unsigned ldsw = (unsigned)wid * 1024u;
    const int aoff = lds_byte(wr * 64 + fr, fq * 8), boff = lds_byte(wc * 32 + fr, fq * 8);
#define PG8_SA(b, h) (((b) * 2 + (h)) * HTB)
#define PG8_SB(b, h) ((4 + (b) * 2 + (h)) * HTB)
#define PG8_STAGE(bufoff, gbase, voff) do { _Pragma("unroll") for (int _i = 0; _i < 2; ++_i) \
        __builtin_amdgcn_global_load_lds((const unsigned*)((const char*)(gbase) + (voff)[_i]), (LAS unsigned*)(lds + (bufoff) + ldsw + _i * 8192), 16, 0, 0); } while (0)
#define PG8_LDA(dst, b, h) do { _Pragma("unroll") for (int m = 0; m < 4; ++m) _Pragma("unroll") for (int k = 0; k < 2; ++k) dst[m][k] = *(const LAS bf16x8*)(lds + PG8_SA(b, h) + aoff + m * 2048 + k * 1024); } while (0)
#define PG8_LDB(dst, b, h) do { _Pragma("unroll") for (int n = 0; n < 2; ++n) _Pragma("unroll") for (int k = 0; k < 2; ++k) dst[n][k] = *(const LAS bf16x8*)(lds + PG8_SB(b, h) + boff + n * 2048 + k * 1024); } while (0)
#define PG8_MMA(ai, bj, At, Bt) do { __builtin_amdgcn_s_setprio(1); _Pragma("unroll") for (int m = 0; m < 4; ++m) _Pragma("unroll") for (int n = 0; n < 2; ++n) _Pragma("unroll") for (int k = 0; k < 2; ++k) \
        acc[ai][bj][m][n] = __builtin_amdgcn_mfma_f32_16x16x32_bf16(Bt[n][k], At[m][k], acc[ai][bj][m][n], 0, 0, 0); __builtin_amdgcn_s_setprio(0); } while (0)
#define PG8_WAIT_V(n) asm volatile("s_waitcnt vmcnt(" #n ")" ::: "memory")
#define PG8_WAIT_L(n) asm volatile("s_waitcnt lgkmcnt(" #n ")" ::: "memory")
#define PG8_BAR __builtin_amdgcn_s_barrier()
#define PG8_SCHED __builtin_amdgcn_sched_barrier(0)
    Unit cur, nxt; int ui = 0;
    if (!S.next(0, cur)) return;
    f32x4 acc[2][2][4][2];
#pragma unroll
    for (int a = 0; a < 2; ++a)
#pragma unroll
        for (int b = 0; b < 2; ++b)
#pragma unroll
            for (int m = 0; m < 4; ++m)
#pragma unroll
                for (int n = 0; n < 2; ++n) acc[a][b][m][n] = (f32x4){0.f, 0.f, 0.f, 0.f};
    bf16x8 At[4][2], B0[2][2], B1[2][2];
    const char* cA = (const char*)g.A + (size_t)cur.pm * tstep; const char* cB = (const char*)g.Bt + (size_t)cur.pn * tstep;
    PG8_STAGE(PG8_SB(0, 0), cB, voffB); PG8_STAGE(PG8_SA(0, 0), cA, voffA); PG8_STAGE(PG8_SB(0, 1), cB + hstep, voffB); PG8_STAGE(PG8_SA(0, 1), cA + hstep, voffA);
    if (wr == 1) PG8_BAR;
    PG8_WAIT_V(4); PG8_BAR;
    PG8_STAGE(PG8_SB(1, 0), cB + kstep, voffB); PG8_STAGE(PG8_SA(1, 0), cA + kstep, voffA); PG8_STAGE(PG8_SB(1, 1), cB + hstep + kstep, voffB);
    PG8_WAIT_V(6); PG8_BAR;
    for (;;) {
        const bool has_next = S.next(ui + 1, nxt);
        const char* nA = has_next ? (const char*)g.A + (size_t)nxt.pm * tstep : cA; const char* nB = has_next ? (const char*)g.Bt + (size_t)nxt.pn * tstep : cB;
        for (int t = 0; t < nt; t += 2) {
            const bool last = (t == nt - 2);
            const char* a1 = cA + (size_t)(t + 1) * kstep;
            const char* a2 = last ? nA : cA + (size_t)(t + 2) * kstep; const char* b2 = last ? nB : cB + (size_t)(t + 2) * kstep;
            const char* a3 = a2 + kstep; const char* b3 = b2 + kstep;
            PG8_LDB(B0, 0, 0); PG8_SCHED; PG8_LDA(At, 0, 0); PG8_STAGE(PG8_SA(1, 1), a1 + hstep, voffA);
            PG8_WAIT_L(8); PG8_BAR; PG8_WAIT_L(0); PG8_MMA(0, 0, At, B0); PG8_BAR; PG8_SCHED;
            PG8_LDB(B1, 0, 1); PG8_STAGE(PG8_SB(0, 0), b2, voffB);
            PG8_BAR; PG8_WAIT_L(0); PG8_MMA(0, 1, At, B1); PG8_BAR;
            PG8_LDA(At, 0, 1); PG8_STAGE(PG8_SA(0, 0), a2, voffA);
            PG8_BAR; PG8_WAIT_L(0); PG8_MMA(1, 0, At, B0); PG8_BAR; PG8_SCHED;
            PG8_STAGE(PG8_SB(0, 1), b2 + hstep, voffB);
            PG8_WAIT_V(6); PG8_BAR; PG8_MMA(1, 1, At, B1); PG8_BAR;
            PG8_LDB(B0, 1, 0); PG8_SCHED; PG8_LDA(At, 1, 0); PG8_STAGE(PG8_SA(0, 1), a2 + hstep, voffA);
            PG8_WAIT_L(8); PG8_BAR; PG8_WAIT_L(0); PG8_MMA(0, 0, At, B0); PG8_BAR; PG8_SCHED;
            PG8_LDB(B1, 1, 1); PG8_STAGE(PG8_SB(1, 0), b3, voffB);
            PG8_BAR; PG8_WAIT_L(0); PG8_MMA(0, 1, At, B1); PG8_BAR;
            PG8_LDA(At, 1, 1); PG8_STAGE(PG8_SA(1, 0), a3, voffA);
            PG8_BAR; PG8_WAIT_L(0); PG8_MMA(1, 0, At, B0); PG8_BAR; PG8_SCHED;
            PG8_STAGE(PG8_SB(1, 1), b3 + hstep, voffB);
            PG8_WAIT_V(6); PG8_BAR; PG8_MMA(1, 1, At, B1); PG8_BAR;
        }
        E(acc, cur, wr, wc, fr, fq);
        if (!has_next) break;
#pragma unroll
        for (int a = 0; a < 2; ++a)
#pragma unroll
            for (int b = 0; b < 2; ++b)
#pragma unroll
                for (int m = 0; m < 4; ++m)
#pragma unroll
                    for (int n = 0; n < 2; ++n) acc[a][b][m][n] = (f32x4){0.f, 0.f, 0.f, 0.f};
        cur = nxt; cA = nA; cB = nB; ++ui;
    }
    PG8_WAIT_V(0);
    if (wr == 0) PG8_BAR;
    PG8_BAR;
#undef PG8_SA
#undef PG8_SB
#undef PG8_STAGE
#undef PG8_LDA
#undef PG8_LDB
#undef PG8_MMA
#undef PG8_WAIT_V
#undef PG8_WAIT_L
#undef PG8_BAR
#undef PG8_SCHED
}
}
using pg8::Unit;

struct EpiProj {
    static constexpr bool PERM = true;
    bf16_t* O; float* DT;
    __device__ __forceinline__ void operator()(const f32x4 (&acc)[2][2][4][2], const Unit& u, int wr, int wc, int fr, int fq) const {
        const int row0 = u.pm * 256 + wr * 64 + fr, col0 = u.pn * 256 + wc * 32 + 8 * fq;
        const int act = (u.pn < 8 || (u.pn >= 24 && u.pn < 28)) ? 1 : ((u.pn >= 28 && u.pn < 44) ? 2 : 0);
#pragma unroll
        for (int ai = 0; ai < 2; ++ai)
#pragma unroll
            for (int m = 0; m < 4; ++m) {
                const int row = row0 + ai * 128 + m * 16;
                bf16_t* rowp = O + (size_t)row * NPROJ + col0;
#pragma unroll
                for (int bj = 0; bj < 2; ++bj) {
                    f32x4 v0 = acc[ai][bj][m][0], v1 = acc[ai][bj][m][1];
                    if (u.pn == 44 && bj == 0 && wc == 0) { float* d = DT + (size_t)row * 32 + 8 * fq; *(f32x4*)d = v0; *(f32x4*)(d + 4) = v1; }
                    if (act == 1) {
#pragma unroll
                        for (int j = 0; j < 4; ++j) { v0[j] = siluf_(v0[j]); v1[j] = siluf_(v1[j]); }
                    } else if (act == 2) {
#pragma unroll
                        for (int j = 0; j < 4; ++j) { v0[j] = sigmoidf_(v0[j]); v1[j] = sigmoidf_(v1[j]); }
                    }
                    u32x4 w; w.x = cvt_pk_bf16(v0[0], v0[1]); w.y = cvt_pk_bf16(v0[2], v0[3]); w.z = cvt_pk_bf16(v1[0], v1[1]); w.w = cvt_pk_bf16(v1[2], v1[3]);
                    *(u32x4*)(rowp + bj * 128) = w;
                }
            }
    }
};
struct EpiGlu {
    static constexpr bool PERM = true;
    const bf16_t* YB; const bf16_t* PROJ; const float* bias; bf16_t* O;
    __device__ __forceinline__ void operator()(const f32x4 (&acc)[2][2][4][2], const Unit& u, int wr, int wc, int fr, int fq) const {
        const int row0 = u.pm * 256 + wr * 64 + fr, col0 = u.pn * 256 + wc * 32 + 8 * fq;
#pragma unroll
        for (int bj = 0; bj < 2; ++bj) {
            const int col = col0 + bj * 128;
            const f32x4 b0 = *(const f32x4*)(bias + col), b1 = *(const f32x4*)(bias + col + 4);
#pragma unroll
            for (int ai = 0; ai < 2; ++ai) {
                u32x4 yb[4], zb[4];
#pragma unroll
                for (int m = 0; m < 4; ++m) { const int row = row0 + ai * 128 + m * 16;
                    yb[m] = *(const u32x4*)(YB + (size_t)row * 1024 + col); zb[m] = *(const u32x4*)(PROJ + (size_t)row * NPROJ + C_ZB + col); }
#pragma unroll
                for (int m = 0; m < 4; ++m) {
                    const int row = row0 + ai * 128 + m * 16;
                    const f32x4 v0 = acc[ai][bj][m][0] + b0, v1 = acc[ai][bj][m][1] + b1;
                    u32x4 w;
                    w.x = cvt_pk_bf16(lo_bf(yb[m].x) * sigmoidf_(v0[0]) * lo_bf(zb[m].x), hi_bf(yb[m].x) * sigmoidf_(v0[1]) * hi_bf(zb[m].x));
                    w.y = cvt_pk_bf16(lo_bf(yb[m].y) * sigmoidf_(v0[2]) * lo_bf(zb[m].y), hi_bf(yb[m].y) * sigmoidf_(v0[3]) * hi_bf(zb[m].y));
                    w.z = cvt_pk_bf16(lo_bf(yb[m].z) * sigmoidf_(v1[0]) * lo_bf(zb[m].z), hi_bf(yb[m].z) * sigmoidf_(v1[1]) * hi_bf(zb[m].z));
                    w.w = cvt_pk_bf16(lo_bf(yb[m].w) * sigmoidf_(v1[2]) * lo_bf(zb[m].w), hi_bf(yb[m].w) * sigmoidf_(v1[3]) * hi_bf(zb[m].w));
                    *(u32x4*)(O + (size_t)row * 1024 + col) = w;
                }
                asm volatile("" ::: "memory");
            }
        }
    }
};
template <int SECOND> struct EpiMix {
    static constexpr bool PERM = true;
    const bf16_t* PROJ; const bf16_t* PREV; bf16_t* O;
    __device__ __forceinline__ void operator()(const f32x4 (&acc)[2][2][4][2], const Unit& u, int wr, int wc, int fr, int fq) const {
        const int row0 = u.pm * 256 + wr * 64 + fr, col0 = u.pn * 256 + wc * 32 + 8 * fq;
#pragma unroll
        for (int ai = 0; ai < 2; ++ai)
#pragma unroll
            for (int bj = 0; bj < 2; ++bj) {
                const int col = col0 + bj * 128;
                u32x4 gt[4], pv[4];
#pragma unroll
                for (int m = 0; m < 4; ++m) { const int row = row0 + ai * 128 + m * 16;
                    gt[m] = *(const u32x4*)(PROJ + (size_t)row * NPROJ + (SECOND ? C_GB : C_GA) + col);
                    if (SECOND) pv[m] = *(const u32x4*)(PREV + (size_t)row * 2048 + col); }
#pragma unroll
                for (int m = 0; m < 4; ++m) {
                    const int row = row0 + ai * 128 + m * 16;
                    const f32x4 v0 = acc[ai][bj][m][0], v1 = acc[ai][bj][m][1];
                    float o[8] = {lo_bf(gt[m].x) * v0[0], hi_bf(gt[m].x) * v0[1], lo_bf(gt[m].y) * v0[2], hi_bf(gt[m].y) * v0[3],
                                  lo_bf(gt[m].z) * v1[0], hi_bf(gt[m].z) * v1[1], lo_bf(gt[m].w) * v1[2], hi_bf(gt[m].w) * v1[3]};
                    if (SECOND) {
                        o[0] += lo_bf(pv[m].x); o[1] += hi_bf(pv[m].x); o[2] += lo_bf(pv[m].y); o[3] += hi_bf(pv[m].y);
                        o[4] += lo_bf(pv[m].z); o[5] += hi_bf(pv[m].z); o[6] += lo_bf(pv[m].w); o[7] += hi_bf(pv[m].w);
                    }
                    u32x4 w; w.x = cvt_pk_bf16(o[0], o[1]); w.y = cvt_pk_bf16(o[2], o[3]); w.z = cvt_pk_bf16(o[4], o[5]); w.w = cvt_pk_bf16(o[6], o[7]);
                    *(u32x4*)(O + (size_t)row * 2048 + col) = w;
                }
                asm volatile("" ::: "memory");
            }
    }
};
struct EpiOut {
    static constexpr bool PERM = false;
    const float* xp; const float* xs; float* out; float* rowsq;
    __device__ __forceinline__ void operator()(const f32x4 (&acc)[2][2][4][2], const Unit& u, int wr, int wc, int fr, int fq) const {
        const int row0 = u.pm * 256 + wr * 64 + fr, col0 = u.pn * 256 + wc * 32 + 4 * fq;
#pragma unroll
        for (int ai = 0; ai < 2; ++ai)
#pragma unroll
            for (int m = 0; m < 4; ++m) {
                const int row = row0 + ai * 128 + m * 16;
                const bool ok = row < 8320;
                const float* hp = row < 8192 ? xp + (size_t)row * 2048 : xs + (size_t)(ok ? row - 8192 : 0) * 2048;
                float s = 0.f;
                if (ok) {
#pragma unroll
                    for (int bj = 0; bj < 2; ++bj)
#pragma unroll
                        for (int n = 0; n < 2; ++n) {
                            const int col = col0 + bj * 128 + n * 16;
                            const f32x4 o = *(const f32x4*)(hp + col) + acc[ai][bj][m][n];
                            *(f32x4*)(out + (size_t)row * 2048 + col) = o;
                            s += o[0] * o[0] + o[1] * o[1] + o[2] * o[2] + o[3] * o[3];
                        }
                }
                s += __shfl_xor(s, 16); s += __shfl_xor(s, 32);
                if (ok && fq == 0) rowsq[(size_t)row * 32 + u.pn * 4 + wc] = s;
            }
    }
};

__device__ __forceinline__ int remap_in(int n) { return n < 5120 ? n : (n < 5152 ? C_DT + (n - 5120) : n - 32); }
__device__ __forceinline__ void phase0(PP p, LAS unsigned char* lds, const int tid) {
    const int bid = blockIdx.x, nb = gridDim.x, wid = tid >> 6, lane = tid & 63;
    {
        unsigned* ctl = (unsigned*)(p->ws + WS_CTL);
        if (bid == 0 && tid < 64) ctl[tid] = 0u;
    }
    {
        bf16_t* xn = (bf16_t*)(p->ws + WS_R1); const float* nw = p->in[7];
        for (int r = bid * 8 + wid; r < MP; r += nb * 8) {
            const float* src = nullptr;
            if (r < 8192) src = p->in[0] + (size_t)r * 2048;
            else if (r < 8320) src = p->in[1] + (size_t)(r - 8192) * 2048;
            else if (r < 8336) src = p->in[6] + (size_t)(r - 8320) * 2048;
            u32x2* dst = (u32x2*)(xn + (size_t)r * 2048);
            if (!src) {
#pragma unroll
                for (int i = 0; i < 8; ++i) dst[i * 64 + lane] = (u32x2){0u, 0u};
                continue;
            }
            f32x4 v[8]; float ss = 0.f;
#pragma unroll
            for (int i = 0; i < 8; ++i) { v[i] = ((const f32x4*)src)[i * 64 + lane]; ss += v[i][0] * v[i][0] + v[i][1] * v[i][1] + v[i][2] * v[i][2] + v[i][3] * v[i][3]; }
#pragma unroll
            for (int o = 32; o >= 1; o >>= 1) ss += __shfl_xor(ss, o);
            const float rs = rsqrtf(ss * (1.0f / 2048.0f) + 1e-5f);
#pragma unroll
            for (int i = 0; i < 8; ++i) { const f32x4 w = ((const f32x4*)nw)[i * 64 + lane]; u32x2 o; o.x = cvt_pk_bf16(v[i][0] * rs * w[0], v[i][1] * rs * w[1]); o.y = cvt_pk_bf16(v[i][2] * rs * w[2], v[i][3] * rs * w[3]); dst[i * 64 + lane] = o; }
        }
    }
    {
        LAS float* tile = (LAS float*)lds;
#define WT_DECODE(job_, src_, dst_, N_, K_, n0_, k0_, remap_) do { int j_ = (job_); int nt_, kt_; remap_ = false; \
            if (j_ < 5648) { src_ = p->in[8]; dst_ = (bf16_t*)(p->ws + WS_WTIN); N_ = 11296; K_ = 2048; nt_ = j_ >> 4; kt_ = j_ & 15; remap_ = true; } \
            else if ((j_ -= 5648) < 1024) { src_ = p->in[15]; dst_ = (bf16_t*)(p->ws + WS_WTA); N_ = 2048; K_ = 2048; nt_ = j_ >> 4; kt_ = j_ & 15; } \
            else if ((j_ -= 1024) < 256) { src_ = p->in[24]; dst_ = (bf16_t*)(p->ws + WS_WTGLU); N_ = 1024; K_ = 1024; nt_ = j_ >> 3; kt_ = j_ & 7; } \
            else if ((j_ -= 256) < 512) { src_ = p->in[26]; dst_ = (bf16_t*)(p->ws + WS_WTB); N_ = 2048; K_ = 1024; nt_ = j_ >> 3; kt_ = j_ & 7; } \
            else { j_ -= 512; src_ = p->in[27]; dst_ = (bf16_t*)(p->ws + WS_WTOUT); N_ = 2048; K_ = 2048; nt_ = j_ >> 4; kt_ = j_ & 15; } \
            n0_ = nt_ * 32; k0_ = kt_ * 128; } while (0)
        const int kr0 = tid >> 3, c4 = tid & 7;
        int job = bid;
        const float* src; bf16_t* dst; int N, K, n0, k0; bool remap;
        f32x4 v0 = (f32x4){0.f, 0.f, 0.f, 0.f}, v1 = v0;
        if (job < 8464) { WT_DECODE(job, src, dst, N, K, n0, k0, remap);
            v0 = *(const f32x4*)(src + (size_t)(k0 + kr0) * N + n0 + c4 * 4); v1 = *(const f32x4*)(src + (size_t)(k0 + kr0 + 64) * N + n0 + c4 * 4); }
        while (job < 8464) {
            tile[kr0 * 33 + c4 * 4 + 0] = v0[0]; tile[kr0 * 33 + c4 * 4 + 1] = v0[1]; tile[kr0 * 33 + c4 * 4 + 2] = v0[2]; tile[kr0 * 33 + c4 * 4 + 3] = v0[3];
            tile[(kr0 + 64) * 33 + c4 * 4 + 0] = v1[0]; tile[(kr0 + 64) * 33 + c4 * 4 + 1] = v1[1]; tile[(kr0 + 64) * 33 + c4 * 4 + 2] = v1[2]; tile[(kr0 + 64) * 33 + c4 * 4 + 3] = v1[3];
            bf16_t* cdst = dst; const int cK = K, cn0 = n0, ck0 = k0; const bool cremap = remap;
            job += nb;
            if (job < 8464) { WT_DECODE(job, src, dst, N, K, n0, k0, remap);
                v0 = *(const f32x4*)(src + (size_t)(k0 + kr0) * N + n0 + c4 * 4); v1 = *(const f32x4*)(src + (size_t)(k0 + kr0 + 64) * N + n0 + c4 * 4); }
            __syncthreads();
            { const int n = tid >> 4, k8 = tid & 15; float f[8];
#pragma unroll
              for (int q = 0; q < 8; ++q) f[q] = tile[(k8 * 8 + q) * 33 + n];
              int nd = cn0 + n; if (cremap) nd = remap_in(nd);
              u32x4 o; o.x = cvt_pk_bf16(f[0], f[1]); o.y = cvt_pk_bf16(f[2], f[3]); o.z = cvt_pk_bf16(f[4], f[5]); o.w = cvt_pk_bf16(f[6], f[7]);
              *(u32x4*)(cdst + (size_t)nd * cK + ck0 + k8 * 8) = o; }
            __syncthreads();
        }
#undef WT_DECODE
    }
}

__device__ __forceinline__ void phase2(PP p, const int tid) {
    const int wid = tid >> 6, lane = tid & 63;
    const int gw = blockIdx.x * 8 + wid, nw = gridDim.x * 8;
    const bf16_t* proj = (const bf16_t*)(p->ws + WS_PROJ);
    bf16_t* XS = (bf16_t*)(p->ws + WS_R2); bf16_t* XT = (bf16_t*)(p->ws + WS_R3);
    bf16_t* BN = (bf16_t*)(p->ws + WS_BN); bf16_t* CN = (bf16_t*)(p->ws + WS_CN); bf16_t* BT = (bf16_t*)(p->ws + WS_BT);
    const float* cw = p->in[9]; const float* cb = p->in[10];
#define CONV_LOAD(it_, dstv_) do { const int cblk_ = (it_) % 24, r_ = (it_) / 24, tau8_ = r_ % 264, b_ = r_ / 264; const int ch_ = cblk_ * 128 + 2 * lane, tp0_ = tau8_ * 8 - 48; \
        _Pragma("unroll") for (int k_ = 0; k_ < 11; ++k_) { const int tp_ = tp0_ - 3 + k_; dstv_[k_] = (tp0_ >= 0 && tp_ >= 0) ? *(const unsigned*)(proj + (size_t)prow(b_, tp_) * NPROJ + C_XBC + ch_) : 0u; } } while (0)
    {
        unsigned cur[11], nxt[11];
#pragma unroll
        for (int k = 0; k < 11; ++k) { cur[k] = 0u; nxt[k] = 0u; }
        if (gw < 4 * 264 * 24) CONV_LOAD(gw, cur);
        for (int it = gw; it < 4 * 264 * 24; it += nw) {
            if (it + nw < 4 * 264 * 24) CONV_LOAD(it + nw, nxt);
            const int cblk = it % 24, r = it / 24, tau8 = r % 264, b = r / 264;
            const int ch = cblk * 128 + 2 * lane;
            const int tp0 = tau8 * 8 - 48;
            float ov0[8], ov1[8];
            if (tp0 < 0) {
#pragma unroll
                for (int j = 0; j < 8; ++j) { ov0[j] = 0.f; ov1[j] = 0.f; }
            } else {
                const f32x2 w0 = *(const f32x2*)(cw + ch), w1 = *(const f32x2*)(cw + 3072 + ch), w2 = *(const f32x2*)(cw + 6144 + ch), w3 = *(const f32x2*)(cw + 9216 + ch), bias = *(const f32x2*)(cb + ch);
#pragma unroll
                for (int j = 0; j < 8; ++j) {
                    ov0[j] = siluf_(bias[0] + w0[0] * lo_bf(cur[j]) + w1[0] * lo_bf(cur[j + 1]) + w2[0] * lo_bf(cur[j + 2]) + w3[0] * lo_bf(cur[j + 3]));
                    ov1[j] = siluf_(bias[1] + w0[1] * hi_bf(cur[j]) + w1[1] * hi_bf(cur[j + 1]) + w2[1] * hi_bf(cur[j + 2]) + w3[1] * hi_bf(cur[j + 3]));
                }
                if (ch >= 2048) {
#pragma unroll
                    for (int j = 0; j < 8; ++j) {
                        const int row = prow(b, tp0 + j); const unsigned o = cvt_pk_bf16(ov0[j], ov1[j]);
                        if (ch < 2560) *(unsigned*)(BN + (size_t)row * 512 + ch - 2048) = o;
                        else *(unsigned*)(CN + (size_t)row * 512 + ch - 2560) = o;
                    }
                }
            }
            const int c = tau8 >> 3, l0 = (tau8 & 7) * 8;
            u32x4 o0, o1;
            o0.x = cvt_pk_bf16(ov0[0], ov0[1]); o0.y = cvt_pk_bf16(ov0[2], ov0[3]); o0.z = cvt_pk_bf16(ov0[4], ov0[5]); o0.w = cvt_pk_bf16(ov0[6], ov0[7]);
            o1.x = cvt_pk_bf16(ov1[0], ov1[1]); o1.y = cvt_pk_bf16(ov1[2], ov1[3]); o1.z = cvt_pk_bf16(ov1[4], ov1[5]); o1.w = cvt_pk_bf16(ov1[6], ov1[7]);
            if (ch < 2048) { const int h = ch >> 6, pp = ch & 63; bf16_t* d = XT + ((((size_t)(b * 33 + c) * 32 + h) * 64 + pp) * 64 + l0); *(u32x4*)d = o0; *(u32x4*)(d + 64) = o1; }
            else if (ch < 2560) { const int g = (ch - 2048) >> 7, n = (ch - 2048) & 127; bf16_t* d = BT + ((((size_t)(b * 33 + c) * 4 + g) * 128 + n) * 64 + l0); *(u32x4*)d = o0; *(u32x4*)(d + 64) = o1; }
#pragma unroll
            for (int k = 0; k < 11; ++k) cur[k] = nxt[k];
        }
    }
#undef CONV_LOAD
    const float* sc = p->in[3];
    for (int it = gw; it < 128 * 48; it += nw) {
        const int cblk = it % 48, bs = it / 48, ch = cblk * 64 + lane, row = 8192 + bs;
        const float p0 = sc[(size_t)(bs * 3 + 0) * 3072 + ch], p1 = sc[(size_t)(bs * 3 + 1) * 3072 + ch], p2 = sc[(size_t)(bs * 3 + 2) * 3072 + ch];
        const float uu = bf2f(proj[(size_t)row * NPROJ + C_XBC + ch]);
        const float v = siluf_(cb[ch] + cw[ch] * p0 + cw[3072 + ch] * p1 + cw[6144 + ch] * p2 + cw[9216 + ch] * uu);
        const bf16_t o = f2bf(v);
        if (ch < 2048) XS[(size_t)row * 2048 + ch] = o;
        else if (ch < 2560) BN[(size_t)row * 512 + ch - 2048] = o;
        else CN[(size_t)row * 512 + ch - 2560] = o;
        float* oc = p->out + O_CONVS + (size_t)bs * 3 * 3072 + ch;
        oc[0] = p1; oc[3072] = p2; oc[6144] = uu;
    }
    const int gt = blockIdx.x * 512 + tid, ntt = gridDim.x * 512;
    for (int i = gt; i < 4 * 3 * 3072; i += ntt) {
        const int ch = i % 3072, k = (i / 3072) % 3, b = i / 9216;
        p->out[O_CONVP + i] = bf2f(proj[(size_t)prow(b, 2061 + k) * NPROJ + C_XBC + ch]);
    }
    const float* DT = (const float*)(p->ws + WS_DT); float* DTS = (float*)(p->ws + WS_DTS); const float* dtb = p->in[11];
    for (int i = gt; i < 8336 * 32; i += ntt) DTS[i] = softplusf_(DT[i] + dtb[i & 31]);
}

#define MFMA16(a, b, c) __builtin_amdgcn_mfma_f32_16x16x32_bf16((a), (b), (c), 0, 0, 0)

__device__ __forceinline__ void ssd_prompt_unit(PP p, LAS unsigned char* lds, int b, int h, const int tid) {
    const int wid = tid >> 6, lane = tid & 63, fr = lane & 15, fq = lane >> 4, g = h >> 3;
    LAS bf16_t* Cs = (LAS bf16_t*)(lds);
    LAS bf16_t* Bs = (LAS bf16_t*)(lds + 17408);
    LAS bf16_t* BTs = (LAS bf16_t*)(lds + 34816);
    LAS bf16_t* XTs = (LAS bf16_t*)(lds + 53248);
    LAS bf16_t* XTw = (LAS bf16_t*)(lds + 62464);
    LAS bf16_t* Ms = (LAS bf16_t*)(lds + 71680);
    LAS bf16_t* Hs = (LAS bf16_t*)(lds + 80896);
    LAS float* sm = (LAS float*)(lds + 98304);
    LAS bf16_t* Zs = (LAS bf16_t*)(lds + 100352);
    LAS bf16_t* Ys = (LAS bf16_t*)(lds + 109568);
    const bf16_t* proj = (const bf16_t*)(p->ws + WS_PROJ);
    const bf16_t* XT = (const bf16_t*)(p->ws + WS_R3); const bf16_t* BT = (const bf16_t*)(p->ws + WS_BT);
    const bf16_t* BN = (const bf16_t*)(p->ws + WS_BN); const bf16_t* CN = (const bf16_t*)(p->ws + WS_CN);
    const float* DT = (const float*)(p->ws + WS_DTS);
    bf16_t* Y = (bf16_t*)(p->ws + WS_R1); float* GSQ = (float*)(p->ws + WS_GSQ);
    const float Ah = -expf(p->in[12][h]), Dh = p->in[13][h];
    for (int i = tid; i < 64 * 136 / 2; i += 512) ((LAS unsigned*)Hs)[i] = 0u;
    f32x4 Hacc[4];
#pragma unroll
    for (int t = 0; t < 4; ++t) Hacc[t] = (f32x4){0.f, 0.f, 0.f, 0.f};
    const int tr = wid >> 1, tb2 = (wid & 1) * 2, tb4 = (wid & 1) * 4;
    u32x4 gc[2], gb[2], gbt[2], gx, gz; float gdt;
#define SSD_ROW(c_, l_) ((c_) == 0 ? ((l_) >= 48 ? 8320 + (l_) - 48 : -1) : b * 2048 + ((c_) - 1) * 64 + (l_))
#define SSD_PREFETCH(c_) do { \
        { const int rl_ = SSD_ROW(c_, lane); gdt = rl_ >= 0 ? DT[(size_t)rl_ * 32 + h] : 0.f; } \
        _Pragma("unroll") for (int i_ = 0; i_ < 2; ++i_) { \
            const int e_ = tid + i_ * 512, row_ = e_ >> 4, v_ = e_ & 15; const int rg_ = SSD_ROW(c_, row_); \
            if (rg_ >= 0) { gc[i_] = *(const u32x4*)(CN + (size_t)rg_ * 512 + g * 128 + v_ * 8); gb[i_] = *(const u32x4*)(BN + (size_t)rg_ * 512 + g * 128 + v_ * 8); } \
            else { gc[i_] = (u32x4){0u, 0u, 0u, 0u}; gb[i_] = (u32x4){0u, 0u, 0u, 0u}; } \
            gbt[i_] = *(const u32x4*)(BT + (((size_t)(b * 33 + (c_)) * 4 + g) * 128) * 64 + (size_t)e_ * 8); } \
        gx = *(const u32x4*)(XT + ((((size_t)(b * 33 + (c_)) * 32 + h) * 64) * 64) + (size_t)tid * 8); \
        { const int rg_ = SSD_ROW(c_, tid >> 3); gz = rg_ >= 0 ? *(const u32x4*)(proj + (size_t)rg_ * NPROJ + C_ZA + 64 * h + (tid & 7) * 8) : (u32x4){0u, 0u, 0u, 0u}; } \
    } while (0)
    SSD_PREFETCH(0);
    for (int c = 0; c < 33; ++c) {
        const float dtv = gdt;
        float ac = dtv * Ah;
#pragma unroll
        for (int o = 1; o < 64; o <<= 1) { const float t = __shfl_up(ac, o); if (lane >= o) ac += t; }
        const float aend = __shfl(ac, 63);
        const float cdecay = __expf(aend);
        const float wl = dtv * __expf(aend - ac);
        if (wid == 0) { sm[lane] = dtv; sm[64 + lane] = ac; sm[192 + lane] = __expf(ac); }
#pragma unroll
        for (int i = 0; i < 2; ++i) {
            const int e = tid + i * 512;
            { const int row = e >> 4, v = e & 15; *(LAS u32x4*)(Cs + row * 136 + v * 8) = gc[i]; *(LAS u32x4*)(Bs + row * 136 + v * 8) = gb[i]; }
            { const int n = e >> 3, v = e & 7; *(LAS u32x4*)(BTs + n * 72 + v * 8) = gbt[i]; }
        }
        { const int pp = tid >> 3, v = tid & 7; *(LAS u32x4*)(XTs + pp * 72 + v * 8) = gx; *(LAS u32x4*)(Zs + pp * 72 + v * 8) = gz;
          float w8[8];
#pragma unroll
          for (int j = 0; j < 8; ++j) w8[j] = __shfl(wl, v * 8 + j);
          u32x4 xw;
          xw.x = cvt_pk_bf16(lo_bf(gx.x) * w8[0], hi_bf(gx.x) * w8[1]); xw.y = cvt_pk_bf16(lo_bf(gx.y) * w8[2], hi_bf(gx.y) * w8[3]);
          xw.z = cvt_pk_bf16(lo_bf(gx.z) * w8[4], hi_bf(gx.z) * w8[5]); xw.w = cvt_pk_bf16(lo_bf(gx.w) * w8[6], hi_bf(gx.w) * w8[7]);
          *(LAS u32x4*)(XTw + pp * 72 + v * 8) = xw; }
        if (c + 1 < 33) SSD_PREFETCH(c + 1);
        __syncthreads();
        {
            f32x4 cbm[2] = {(f32x4){0.f, 0.f, 0.f, 0.f}, (f32x4){0.f, 0.f, 0.f, 0.f}};
#pragma unroll
            for (int ks = 0; ks < 4; ++ks) {
                const bf16x8 a = *(const LAS bf16x8*)(Cs + (16 * tr + fr) * 136 + ks * 32 + fq * 8);
#pragma unroll
                for (int t = 0; t < 2; ++t) { const bf16x8 bb = *(const LAS bf16x8*)(Bs + (16 * (tb2 + t) + fr) * 136 + ks * 32 + fq * 8); cbm[t] = MFMA16(a, bb, cbm[t]); }
            }
#pragma unroll
            for (int t = 0; t < 2; ++t) {
                const int s_ = 16 * (tb2 + t) + fr; const float as = sm[64 + s_], ds = sm[s_];
#pragma unroll
                for (int i = 0; i < 4; ++i) { const int l = 16 * tr + 4 * fq + i; const float al = sm[64 + l];
                    const float v = (s_ <= l) ? cbm[t][i] * __expf(al - as) * ds : 0.f; Ms[l * 72 + s_] = f2bf(v); }
            }
        }
        __syncthreads();
        {
            f32x4 y[2] = {(f32x4){0.f, 0.f, 0.f, 0.f}, (f32x4){0.f, 0.f, 0.f, 0.f}};
#pragma unroll
            for (int ks = 0; ks < 4; ++ks) {
                const bf16x8 a = *(const LAS bf16x8*)(Cs + (16 * tr + fr) * 136 + ks * 32 + fq * 8);
#pragma unroll
                for (int t = 0; t < 2; ++t) { const bf16x8 bb = *(const LAS bf16x8*)(Hs + (16 * (tb2 + t) + fr) * 136 + ks * 32 + fq * 8); y[t] = MFMA16(a, bb, y[t]); }
            }
#pragma unroll
            for (int i = 0; i < 4; ++i) { const float e = sm[192 + 16 * tr + 4 * fq + i]; y[0][i] *= e; y[1][i] *= e; }
#pragma unroll
            for (int ks = 0; ks < 2; ++ks) {
                const bf16x8 a = *(const LAS bf16x8*)(Ms + (16 * tr + fr) * 72 + ks * 32 + fq * 8);
#pragma unroll
                for (int t = 0; t < 2; ++t) { const bf16x8 bb = *(const LAS bf16x8*)(XTs + (16 * (tb2 + t) + fr) * 72 + ks * 32 + fq * 8); y[t] = MFMA16(a, bb, y[t]); }
            }
#pragma unroll
            for (int i = 0; i < 4; ++i) {
                const int l = 16 * tr + 4 * fq + i;
                float sq = 0.f;
#pragma unroll
                for (int t = 0; t < 2; ++t) {
                    const int pc = 16 * (tb2 + t) + fr;
                    const float x = bf2f(XTs[pc * 72 + l]);
                    const float z = bf2f(Zs[l * 72 + pc]);
                    const float v = (y[t][i] + Dh * x) * z;
                    Ys[l * 72 + pc] = f2bf(v);
                    sq += v * v;
                }
                sq = red16_dpp(sq);
                if (fr == 0) sm[256 + l * 2 + (wid & 1)] = sq;
            }
        }
        {
#pragma unroll
            for (int t = 0; t < 4; ++t) Hacc[t] *= cdecay;
#pragma unroll
            for (int ks = 0; ks < 2; ++ks) {
                const bf16x8 a = *(const LAS bf16x8*)(XTw + (16 * tr + fr) * 72 + ks * 32 + fq * 8);
#pragma unroll
                for (int t = 0; t < 4; ++t) { const bf16x8 bb = *(const LAS bf16x8*)(BTs + (16 * (tb4 + t) + fr) * 72 + ks * 32 + fq * 8); Hacc[t] = MFMA16(a, bb, Hacc[t]); }
            }
        }
        __syncthreads();
#pragma unroll
        for (int t = 0; t < 4; ++t)
#pragma unroll
            for (int i = 0; i < 4; ++i) Hs[(16 * tr + 4 * fq + i) * 136 + 16 * (tb4 + t) + fr] = f2bf(Hacc[t][i]);
        { const int l = tid >> 3, v = tid & 7; const int rg = SSD_ROW(c, l);
          if (rg >= 0) *(u32x4*)(Y + (size_t)rg * 2048 + 64 * h + v * 8) = *(const LAS u32x4*)(Ys + l * 72 + v * 8);
          if (rg >= 0 && v == 0) GSQ[(size_t)rg * 32 + h] = sm[256 + l * 2] + sm[256 + l * 2 + 1]; }
    }
#undef SSD_PREFETCH
#undef SSD_ROW
    float* so = p->out + O_SSDP + ((size_t)(b * 32 + h) * 64) * 128;
#pragma unroll
    for (int t = 0; t < 4; ++t)
#pragma unroll
        for (int i = 0; i < 4; ++i) so[(size_t)(16 * tr + 4 * fq + i) * 128 + 16 * (tb4 + t) + fr] = Hacc[t][i];
    __syncthreads();
}

__device__ __forceinline__ void s5_unit(PP p, LAS unsigned char* lds, int b, int g, const int tid) {
    const int wid = tid >> 6, lane = tid & 63, fr = lane & 15, fq = lane >> 4;
    LAS float* coef = (LAS float*)lds;
    LAS float* table = (LAS float*)(lds + 2048);
    LAS float* wbuf = (LAS float*)(lds + 2048 + 66048 + wid * 8448);
    LAS bf16_t* wbh = (LAS bf16_t*)wbuf;
    const bf16_t* proj = (const bf16_t*)(p->ws + WS_PROJ);
    bf16_t* YB = (bf16_t*)(p->ws + WS_YB);
    const bool sample = (b == 4);
    if (wid == 0) {
        const int n = lane;
        const double step = d_exp((double)p->in[18][g]);
        const double lr = (double)p->in[16][g * 64 + n], li = (double)p->in[17][g * 64 + n];
        const double mag = d_exp(lr * step); double sn, cs; d_sincos(li * step, sn, cs);
        const double ar = mag * cs, ai = mag * sn;
        const double den = lr * lr + li * li, nr = ar - 1.0;
        const double cr = (nr * lr + ai * li) / den, ci = (ai * lr - nr * li) / den;
        double pr = ar, pi = ai;
#pragma unroll
        for (int q = 0; q < 4; ++q) { const double t = pr * pr - pi * pi; pi = 2.0 * pr * pi; pr = t; }
        coef[n * 8 + 0] = (float)ar; coef[n * 8 + 1] = (float)ai; coef[n * 8 + 2] = (float)cr; coef[n * 8 + 3] = (float)ci; coef[n * 8 + 4] = (float)pr; coef[n * 8 + 5] = (float)pi;
    }
    __syncthreads();
    bf16x8 Bf[8];
    {
        const float* bre = p->in[19]; const float* bim = p->in[20];
#pragma unroll
        for (int t8 = 0; t8 < 8; ++t8) {
            const int n = (16 * t8 + fr) & 63; const float cr = coef[n * 8 + 2], ci = coef[n * 8 + 3];
            u32x4 w = (u32x4){0u, 0u, 0u, 0u};
            if (fq < 2) {
                const f32x4 r0 = *(const f32x4*)(bre + (size_t)(g * 64 + n) * 16 + 8 * fq), r1 = *(const f32x4*)(bre + (size_t)(g * 64 + n) * 16 + 8 * fq + 4);
                const f32x4 i0 = *(const f32x4*)(bim + (size_t)(g * 64 + n) * 16 + 8 * fq), i1 = *(const f32x4*)(bim + (size_t)(g * 64 + n) * 16 + 8 * fq + 4);
                f32x4 v0, v1;
                if (t8 < 4) { v0 = cr * r0 - ci * i0; v1 = cr * r1 - ci * i1; } else { v0 = cr * i0 + ci * r0; v1 = cr * i1 + ci * r1; }
                w.x = cvt_pk_bf16(v0[0], v0[1]); w.y = cvt_pk_bf16(v0[2], v0[3]); w.z = cvt_pk_bf16(v1[0], v1[1]); w.w = cvt_pk_bf16(v1[2], v1[3]);
            }
            Bf[t8] = __builtin_bit_cast(bf16x8, w);
        }
    }
    bf16x8 Cf[4];
    {
        const float* cre = p->in[21]; const float* cim = p->in[22];
#pragma unroll
        for (int ks = 0; ks < 4; ++ks) {
            const float* src = (ks < 2 ? cre : cim) + (size_t)(g * 16 + fr) * 64 + 32 * (ks & 1) + 8 * fq;
            f32x4 v0 = *(const f32x4*)src, v1 = *(const f32x4*)(src + 4);
            if (ks >= 2) { v0 = -v0; v1 = -v1; }
            u32x4 w; w.x = cvt_pk_bf16(v0[0], v0[1]); w.y = cvt_pk_bf16(v0[2], v0[3]); w.z = cvt_pk_bf16(v1[0], v1[1]); w.w = cvt_pk_bf16(v1[2], v1[3]);
            Cf[ks] = __builtin_bit_cast(bf16x8, w);
        }
    }
    const float a_re = coef[lane * 8 + 0], a_im = coef[lane * 8 + 1];
    const float dsk = p->in[23][16 * g + fr];
    auto row_of = [&](int c, int t) -> int { return sample ? (8192 + 16 * c + t) : (c == 0 ? 8320 + t : b * 2048 + 16 * (c - 1) + t); };
    auto load_a = [&](int c) -> u32x4 {
        u32x4 a = (u32x4){0u, 0u, 0u, 0u};
        if (fq < 2) a = *(const u32x4*)(proj + (size_t)row_of(c, fr) * NPROJ + C_UB + 16 * g + 8 * fq);
        return a; };
    auto bu_tile = [&](const u32x4 a) {
        const bf16x8 af = __builtin_bit_cast(bf16x8, a);
#pragma unroll
        for (int t8 = 0; t8 < 8; ++t8) {
            const f32x4 r = MFMA16(af, Bf[t8], ((f32x4){0.f, 0.f, 0.f, 0.f}));
#pragma unroll
            for (int i = 0; i < 4; ++i) wbuf[(4 * fq + i) * 132 + 16 * t8 + fr] = r[i];
        }
    };
    if (!sample) {
        u32x4 a_nxt = load_a(wid);
        for (int c = wid; c < 129; c += 8) {
            const u32x4 a_cur = a_nxt; if (c + 8 < 129) a_nxt = load_a(c + 8);
            bu_tile(a_cur);
            float hr = 0.f, hi = 0.f;
#pragma unroll
            for (int t = 0; t < 16; ++t) { const float ur = wbuf[t * 132 + lane], ui = wbuf[t * 132 + 64 + lane];
                const float nr = a_re * hr - a_im * hi + ur; hi = a_re * hi + a_im * hr + ui; hr = nr; }
            table[c * 128 + lane] = hr; table[c * 128 + 64 + lane] = hi;
        }
        __syncthreads();
        if (wid == 0) {
            const float q_re = coef[lane * 8 + 4], q_im = coef[lane * 8 + 5];
            float hr = 0.f, hi = 0.f;
            for (int c = 0; c < 129; ++c) {
                const float lr = table[c * 128 + lane], li = table[c * 128 + 64 + lane];
                table[c * 128 + lane] = hr; table[c * 128 + 64 + lane] = hi;
                const float nr = q_re * hr - q_im * hi + lr; hi = q_re * hi + q_im * hr + li; hr = nr;
            }
            p->out[O_S5RP + (size_t)(b * 64 + g) * 64 + lane] = hr;
            p->out[O_S5IP + (size_t)(b * 64 + g) * 64 + lane] = hi;
        }
        __syncthreads();
    }
    const int cend = sample ? 8 : 129;
    u32x4 a_nxt2 = load_a(wid);
    for (int c = wid; c < cend; c += 8) {
        const u32x4 a_cur = a_nxt2; if (c + 8 < cend) a_nxt2 = load_a(c + 8);
        bu_tile(a_cur);
        if (!sample) {
            float hr = table[c * 128 + lane], hi = table[c * 128 + 64 + lane];
#pragma unroll
            for (int t = 0; t < 16; ++t) { const float ur = wbuf[t * 132 + lane], ui = wbuf[t * 132 + 64 + lane];
                const float nr = a_re * hr - a_im * hi + ur; hi = a_re * hi + a_im * hr + ui; hr = nr;
                wbh[t * 264 + lane] = f2bf(hr); wbh[t * 264 + 64 + lane] = f2bf(hi); }
        } else {
            const float* s_re = p->in[4]; const float* s_im = p->in[5];
#pragma unroll
            for (int t = 0; t < 16; ++t) { const int bs = 16 * c + t; const size_t si = (size_t)(bs * 64 + g) * 64 + lane;
                const float h0r = s_re[si], h0i = s_im[si];
                const float ur = wbuf[t * 132 + lane], ui = wbuf[t * 132 + 64 + lane];
                const float hr = a_re * h0r - a_im * h0i + ur, hi = a_re * h0i + a_im * h0r + ui;
                p->out[O_S5RS + si] = hr; p->out[O_S5IS + si] = hi;
                wbh[t * 264 + lane] = f2bf(hr); wbh[t * 264 + 64 + lane] = f2bf(hi); }
        }
        if (fq < 2) *(LAS u32x4*)(wbh + fr * 264 + 128 + 8 * fq) = a_cur;
        f32x4 y = (f32x4){0.f, 0.f, 0.f, 0.f};
#pragma unroll
        for (int ks = 0; ks < 4; ++ks) { const bf16x8 af = *(const LAS bf16x8*)(wbh + fr * 264 + 32 * ks + 8 * fq); y = MFMA16(af, Cf[ks], y); }
#pragma unroll
        for (int i = 0; i < 4; ++i) {
            const int row = row_of(c, 4 * fq + i);
            const float uu = bf2f(wbh[(4 * fq + i) * 264 + 128 + fr]);
            YB[(size_t)row * 1024 + 16 * g + fr] = f2bf(gelu_tanh(y[i] + dsk * uu));
        }
    }
    __syncthreads();
}

__device__ __forceinline__ void ssd_sample_unit(PP p, LAS unsigned char* lds, int bs, int g, const int tid) {
    const int n4 = tid & 31, row = 8192 + bs, p0 = tid >> 5;
    LAS float* ybuf = (LAS float*)lds;
    LAS float* red = ybuf + 512;
    LAS float* xsf = ybuf + 544;
    LAS float* zsf = ybuf + 1056;
    LAS float* hsc = ybuf + 1568;
    const bf16_t* proj = (const bf16_t*)(p->ws + WS_PROJ);
    const bf16_t* XS = (const bf16_t*)(p->ws + WS_R2);
    const bf16_t* BN = (const bf16_t*)(p->ws + WS_BN); const bf16_t* CN = (const bf16_t*)(p->ws + WS_CN);
    const float* DT = (const float*)(p->ws + WS_DTS);
    bf16_t* Y = (bf16_t*)(p->ws + WS_R1); float* GSQ = (float*)(p->ws + WS_GSQ);
    const float* s0 = p->in[2] + ((size_t)(bs * 32 + 8 * g) * 64 + p0) * 128 + 4 * n4;
    float* s1 = p->out + O_SSDS + ((size_t)(bs * 32 + 8 * g) * 64 + p0) * 128 + 4 * n4;
    f32x4 cur[8], nxt[8];
#pragma unroll
    for (int j = 0; j < 8; ++j) cur[j] = *(const f32x4*)(s0 + (size_t)(j >> 2) * 8192 + (size_t)(j & 3) * 2048);
    xsf[tid] = bf2f(XS[(size_t)row * 2048 + 512 * g + tid]);
    zsf[tid] = bf2f(proj[(size_t)row * NPROJ + C_ZA + 512 * g + tid]);
    if (tid < 8) { const int h = 8 * g + tid; const float dt = DT[(size_t)row * 32 + h]; hsc[tid * 4] = dt; hsc[tid * 4 + 1] = __expf(-dt * expf(p->in[12][h])); hsc[tid * 4 + 2] = p->in[13][h]; }
    const u32x2 bw = *(const u32x2*)(BN + (size_t)row * 512 + g * 128 + 4 * n4), cw = *(const u32x2*)(CN + (size_t)row * 512 + g * 128 + 4 * n4);
    const f32x4 Bv = (f32x4){lo_bf(bw.x), hi_bf(bw.x), lo_bf(bw.y), hi_bf(bw.y)}, Cv = (f32x4){lo_bf(cw.x), hi_bf(cw.x), lo_bf(cw.y), hi_bf(cw.y)};
    __syncthreads();
#pragma unroll
    for (int hp = 0; hp < 4; ++hp) {
        if (hp < 3) {
#pragma unroll
            for (int j = 0; j < 8; ++j) nxt[j] = *(const f32x4*)(s0 + (size_t)(2 * hp + 2 + (j >> 2)) * 8192 + (size_t)(j & 3) * 2048);
        }
#pragma unroll
        for (int j = 0; j < 8; ++j) {
            const int hh = 2 * hp + (j >> 2), pp = p0 + 16 * (j & 3);
            const float dt = hsc[hh * 4], dA = hsc[hh * 4 + 1], Dh = hsc[hh * 4 + 2];
            const float x = xsf[hh * 64 + pp], dtx = dt * x;
            const f32x4 hn = dA * cur[j] + dtx * Bv;
            *(f32x4*)(s1 + (size_t)hh * 8192 + (size_t)(j & 3) * 2048) = hn;
            float part = Cv[0] * hn[0] + Cv[1] * hn[1] + Cv[2] * hn[2] + Cv[3] * hn[3];
            part = red16_dpp(part); part += __shfl_xor(part, 16);
            if (n4 == 0) ybuf[hh * 64 + pp] = (part + Dh * x) * zsf[hh * 64 + pp];
        }
        if (hp < 3) {
#pragma unroll
            for (int j = 0; j < 8; ++j) cur[j] = nxt[j];
        }
    }
    __syncthreads();
    const float v = ybuf[tid];
    Y[(size_t)row * 2048 + 512 * g + tid] = f2bf(v);
    float sq = v * v;
#pragma unroll
    for (int o = 32; o >= 1; o >>= 1) sq += __shfl_xor(sq, o);
    if ((tid & 63) == 0) red[tid >> 6] = sq;
    __syncthreads();
    if (tid < 8) { float t = 0.f; if (tid == 0) for (int i = 0; i < 8; ++i) t += red[i]; GSQ[(size_t)row * 32 + 8 * g + tid] = t; }
    __syncthreads();
}

__device__ __forceinline__ void phase3(PP p, LAS unsigned char* lds, const int it_lo = 0, const int it_hi = 960) {
    LAS int* qslot = (LAS int*)(lds + LDS_BYTES - 16);
    unsigned* ctr = (unsigned*)(p->ws + WS_CTL);
    for (;;) {
        __syncthreads();
        if (threadIdx.x == 0) *qslot = (int)atomicAdd(ctr, 1u);
        __syncthreads();
        const int it = __builtin_amdgcn_readfirstlane(*qslot) + it_lo;
        if (it >= it_hi) break;
        int tid = threadIdx.x; asm volatile("" : "+v"(tid));
        if (it < 128) ssd_prompt_unit(p, lds, it >> 5, it & 31, tid);
        else if (it < 384) s5_unit(p, lds, (it - 128) >> 6, (it - 128) & 63, tid);
        else if (it < 448) s5_unit(p, lds, 4, it - 384, tid);
        else ssd_sample_unit(p, lds, (it - 448) >> 2, (it - 448) & 3, tid);
    }
}

__device__ __forceinline__ void skinny_kloop(const bf16_t* A, int lda, const bf16_t* Bt, int K, int row0, int col0, int wid, int fr, int fq, f32x4 (&ac)[4]) {
    const int nks = K / 256;
    const bf16_t* ap = A + (size_t)(row0 + fr) * lda + wid * (K / 8) + 8 * fq;
    const bf16_t* bp = Bt + (size_t)(col0 + fr) * K + wid * (K / 8) + 8 * fq;
    for (int ks = 0; ks < nks; ks += 4) {
        bf16x8 a[4], b[4][4];
#pragma unroll
        for (int j = 0; j < 4; ++j) {
            a[j] = *(const bf16x8*)(ap + (ks + j) * 32);
#pragma unroll
            for (int t = 0; t < 4; ++t) b[j][t] = *(const bf16x8*)(bp + (size_t)t * 16 * K + (ks + j) * 32);
        }
#pragma unroll
        for (int j = 0; j < 4; ++j)
#pragma unroll
            for (int t = 0; t < 4; ++t) ac[t] = MFMA16(a[j], b[j][t], ac[t]);
    }
}
template <int MODE>
__device__ __forceinline__ void skinny_job(PP p, LAS unsigned char* lds, int job, const int tid) {
    const int wid = tid >> 6, lane = tid & 63, fr = lane & 15, fq = lane >> 4;
    const int rt = job & 7, cg = job >> 3, row0 = 8192 + 16 * rt, col0 = 64 * cg;
    const bf16_t* PROJ = (const bf16_t*)(p->ws + WS_PROJ);
    LAS f32x4* red = (LAS f32x4*)lds;
    LAS f32x4* red2 = red + 2048;
    LAS float* rs = (LAS float*)(lds + 65536);
    f32x4 ac[4], ac2[4];
#pragma unroll
    for (int t = 0; t < 4; ++t) { ac[t] = (f32x4){0.f, 0.f, 0.f, 0.f}; ac2[t] = (f32x4){0.f, 0.f, 0.f, 0.f}; }
    if (MODE == 0) skinny_kloop((const bf16_t*)(p->ws + WS_YB), 1024, (const bf16_t*)(p->ws + WS_WTGLU), 1024, row0, col0, wid, fr, fq, ac);
    if (MODE == 1) { skinny_kloop((const bf16_t*)(p->ws + WS_R1), 2048, (const bf16_t*)(p->ws + WS_WTA), 2048, row0, col0, wid, fr, fq, ac);
                     skinny_kloop((const bf16_t*)(p->ws + WS_YB2), 1024, (const bf16_t*)(p->ws + WS_WTB), 1024, row0, col0, wid, fr, fq, ac2); }
    if (MODE == 2) skinny_kloop((const bf16_t*)(p->ws + WS_R2), 2048, (const bf16_t*)(p->ws + WS_WTOUT), 2048, row0, col0, wid, fr, fq, ac);
#pragma unroll
    for (int t = 0; t < 4; ++t) { red[(wid * 4 + t) * 64 + lane] = ac[t]; if (MODE == 1) red2[(wid * 4 + t) * 64 + lane] = ac2[t]; }
    __syncthreads();
    const int t = wid & 3, half = wid >> 2;
    float v[2] = {0.f, 0.f}, v2[2] = {0.f, 0.f};
#pragma unroll
    for (int w2 = 0; w2 < 8; ++w2) {
        const f32x4 q = red[(w2 * 4 + t) * 64 + lane]; v[0] += q[2 * half]; v[1] += q[2 * half + 1];
        if (MODE == 1) { const f32x4 q2 = red2[(w2 * 4 + t) * 64 + lane]; v2[0] += q2[2 * half]; v2[1] += q2[2 * half + 1]; }
    }
    const int col = col0 + 16 * t + fr;
#pragma unroll
    for (int e = 0; e < 2; ++e) {
        const int rl = 4 * fq + 2 * half + e, row = row0 + rl;
        if (MODE == 0) {
            const float yb = bf2f(((const bf16_t*)(p->ws + WS_YB))[(size_t)row * 1024 + col]), zb = bf2f(PROJ[(size_t)row * NPROJ + C_ZB + col]);
            ((bf16_t*)(p->ws + WS_YB2))[(size_t)row * 1024 + col] = f2bf(yb * sigmoidf_(v[e] + p->in[25][col]) * zb);
        } else if (MODE == 1) {
            const float ga = bf2f(PROJ[(size_t)row * NPROJ + C_GA + col]), gb = bf2f(PROJ[(size_t)row * NPROJ + C_GB + col]);
            ((bf16_t*)(p->ws + WS_R2))[(size_t)row * 2048 + col] = f2bf(ga * v[e] + gb * v2[e]);
        } else {
            const float o = p->in[1][(size_t)(row - 8192) * 2048 + col] + v[e];
            p->out[(size_t)row * 2048 + col] = o;
            const float sq = red16_dpp(o * o);
            if (fr == 0) rs[rl * 4 + t] = sq;
        }
    }
    __syncthreads();
    if (MODE == 2 && tid < 16) ((float*)(p->ws + WS_ROWSQ))[(size_t)(row0 + tid) * 32 + cg] = (rs[tid * 4] + rs[tid * 4 + 1]) + (rs[tid * 4 + 2] + rs[tid * 4 + 3]);
}

__device__ __forceinline__ void ynorm_fix(PP p, LAS unsigned char* lds, const int tid) {
    const int wid = tid >> 6, lane = tid & 63;
    LAS int* qslot = (LAS int*)(lds + LDS_BYTES - 16);
    unsigned* ctr = (unsigned*)(p->ws + WS_CTL) + 1;
    bf16_t* Y = (bf16_t*)(p->ws + WS_R1); const float* GSQ = (const float*)(p->ws + WS_GSQ); const float* nw = p->in[14];
    for (;;) {
        __syncthreads();
        if (tid == 0) *qslot = (int)atomicAdd(ctr, 1u);
        __syncthreads();
        const int it = *qslot;
        if (it >= 1040) break;
        const int r = it * 8 + wid;
#pragma unroll
        for (int i = 0; i < 4; ++i) {
            const f32x4 q0 = *(const f32x4*)(GSQ + (size_t)r * 32 + 8 * i), q1 = *(const f32x4*)(GSQ + (size_t)r * 32 + 8 * i + 4);
            const float rs = rsqrtf(((q0[0] + q0[1]) + (q0[2] + q0[3]) + (q1[0] + q1[1]) + (q1[2] + q1[3])) * (1.0f / 512.0f) + 1e-5f);
            u32x4* ptr = (u32x4*)(Y + (size_t)r * 2048) + i * 64 + lane;
            const u32x4 v = *ptr;
            const f32x4 w0 = *(const f32x4*)(nw + (i * 64 + lane) * 8), w1 = *(const f32x4*)(nw + (i * 64 + lane) * 8 + 4);
            u32x4 o;
            o.x = cvt_pk_bf16(lo_bf(v.x) * rs * w0[0], hi_bf(v.x) * rs * w0[1]); o.y = cvt_pk_bf16(lo_bf(v.y) * rs * w0[2], hi_bf(v.y) * rs * w0[3]);
            o.z = cvt_pk_bf16(lo_bf(v.z) * rs * w1[0], hi_bf(v.z) * rs * w1[1]); o.w = cvt_pk_bf16(lo_bf(v.w) * rs * w1[2], hi_bf(v.w) * rs * w1[3]);
            *ptr = o;
        }
    }
}

__device__ __forceinline__ void phase7(PP p, const int tid) {
    const int wid = tid >> 6, lane = tid & 63;
    const float* rowsq = (const float*)(p->ws + WS_ROWSQ); const float* fw = p->in[28];
    for (int r = blockIdx.x * 8 + wid; r < 8320; r += gridDim.x * 8) {
        float ssq = lane < 32 ? rowsq[(size_t)r * 32 + lane] : 0.f;
#pragma unroll
        for (int o = 16; o >= 1; o >>= 1) ssq += __shfl_xor(ssq, o);
        ssq = __shfl(ssq, 0);
        const float rs = rsqrtf(ssq * (1.0f / 2048.0f) + 1e-5f);
        f32x4* ptr = (f32x4*)(p->out + (size_t)r * 2048);
#pragma unroll
        for (int i = 0; i < 8; ++i) { const f32x4 w = ((const f32x4*)fw)[i * 64 + lane]; f32x4 v = ptr[i * 64 + lane]; v = v * rs * w; ptr[i * 64 + lane] = v; }
    }
}

__global__ void __launch_bounds__(512) mk_fwd(Params pa, int ph_lo, int ph_hi) {
    extern __shared__ __attribute__((aligned(16))) unsigned char smem[];
    LAS unsigned char* lds = (LAS unsigned char*)smem;
    cg::grid_group grid = cg::this_grid();
#define PH_BEGIN(k) if (ph_lo <= (k) && (k) < ph_hi) { if (ph_lo < (k)) grid.sync();
#define PH_ENV PP p = (PP)__builtin_amdgcn_kernarg_segment_ptr(); asm volatile("" : "+s"(p)); int tid = threadIdx.x; asm volatile("" : "+v"(tid)); \
        const bf16_t* PROJ = (const bf16_t*)(p->ws + WS_PROJ); (void)PROJ;
#define PH_END }
#define BODY0 { PH_ENV phase0(p, lds, tid); }
#define BODY1 { PH_ENV \
        pg8::Gemm g{(const bf16_t*)(p->ws + WS_R1), (const bf16_t*)(p->ws + WS_WTIN), MP, NPROJ, 2048}; \
        pg8::StaticOrder S; S.init(MP, NPROJ, gridDim.x, blockIdx.x); \
        EpiProj E{(bf16_t*)(p->ws + WS_PROJ), (float*)(p->ws + WS_DT)}; \
        pg8::gemm_phase(lds, g, S, E, tid); }
#define BODY2 { PH_ENV phase2(p, tid); }
#define BODY3 { PH_ENV phase3(p, lds); }
#define BODY4 { PH_ENV \
        pg8::Gemm g{(const bf16_t*)(p->ws + WS_YB), (const bf16_t*)(p->ws + WS_WTGLU), 8192, 1024, 1024}; \
        pg8::StaticOrder S; S.init(8192, 1024, gridDim.x, blockIdx.x); \
        EpiGlu E{(const bf16_t*)(p->ws + WS_YB), PROJ, p->in[25], (bf16_t*)(p->ws + WS_YB2)}; \
        pg8::gemm_phase(lds, g, S, E, tid); \
        for (int job = (int)((blockIdx.x + gridDim.x / 2) % gridDim.x); job < 128; job += gridDim.x) skinny_job<0>(p, lds, job, tid); \
        ynorm_fix(p, lds, tid); }
#define BODY5 { PH_ENV \
        pg8::StaticOrder S; S.init(8192, 2048, gridDim.x, blockIdx.x); \
        { pg8::Gemm g{(const bf16_t*)(p->ws + WS_R1), (const bf16_t*)(p->ws + WS_WTA), 8192, 2048, 2048}; \
          EpiMix<0> E{PROJ, nullptr, (bf16_t*)(p->ws + WS_R3)}; \
          pg8::gemm_phase(lds, g, S, E, tid); } \
        { pg8::Gemm g{(const bf16_t*)(p->ws + WS_YB2), (const bf16_t*)(p->ws + WS_WTB), 8192, 2048, 1024}; \
          EpiMix<1> E{PROJ, (const bf16_t*)(p->ws + WS_R3), (bf16_t*)(p->ws + WS_R2)}; \
          pg8::gemm_phase(lds, g, S, E, tid); } \
        for (int job = blockIdx.x; job < 256; job += gridDim.x) skinny_job<1>(p, lds, job, tid); }
#define BODY6 { PH_ENV \
        pg8::Gemm g{(const bf16_t*)(p->ws + WS_R2), (const bf16_t*)(p->ws + WS_WTOUT), 8192, 2048, 2048}; \
        pg8::StaticOrder S; S.init(8192, 2048, gridDim.x, blockIdx.x); \
        EpiOut E{p->in[0], p->in[1], p->out, (float*)(p->ws + WS_ROWSQ)}; \
        pg8::gemm_phase(lds, g, S, E, tid); \
        for (int job = blockIdx.x; job < 256; job += gridDim.x) skinny_job<2>(p, lds, job, tid); }
#define BODY7 { PH_ENV phase7(p, tid); }
    PH_BEGIN(0) BODY0 PH_END
#if DUP_PH == 0
    grid.sync(); BODY0
#endif
    PH_BEGIN(1) BODY1 PH_END
#if DUP_PH == 1
    grid.sync(); BODY1
#endif
    PH_BEGIN(2) BODY2 PH_END
#if DUP_PH == 2
    grid.sync(); BODY2
#endif
    PH_BEGIN(3) BODY3 PH_END
#if DUP_PH == 3
    grid.sync();
    { if (blockIdx.x == 0 && threadIdx.x == 0) *(unsigned*)(pa.ws + WS_CTL) = 0u; }
    grid.sync(); { PH_ENV phase3(p, lds, DUP_LO, DUP_HI); }
#endif
    PH_BEGIN(4) BODY4 PH_END
    PH_BEGIN(5) BODY5 PH_END
#if DUP_PH == 5 || DUP_PH == 56
    grid.sync(); BODY5
#endif
    PH_BEGIN(6) BODY6 PH_END
#if DUP_PH == 6 || DUP_PH == 56
    grid.sync(); BODY6
#endif
    PH_BEGIN(7) BODY7 PH_END
}

extern "C" void kernel_launch(void* const* d_in, const int* in_sizes, int n_in, void* d_out, int out_size, void* d_ws, size_t ws_size, hipStream_t stream) {
    static int grid_blocks = 0;
    if (grid_blocks == 0) {
        if (n_in != 29 || ws_size < WS_END) { fprintf(stderr, "kernel_launch: unexpected n_in %d or ws_size %zu (< %zu)\n", n_in, ws_size, (size_t)WS_END); grid_blocks = -1; return; }
        int dev = 0, cus = 0, per_cu = 0;
        hipGetDevice(&dev);
        hipDeviceGetAttribute(&cus, hipDeviceAttributeMultiprocessorCount, dev);
        if (hipFuncSetAttribute((const void*)mk_fwd, hipFuncAttributeMaxDynamicSharedMemorySize, LDS_BYTES) != hipSuccess) { fprintf(stderr, "kernel_launch: hipFuncSetAttribute failed\n"); grid_blocks = -1; return; }
        if (hipOccupancyMaxActiveBlocksPerMultiprocessor(&per_cu, (const void*)mk_fwd, 512, LDS_BYTES) != hipSuccess || per_cu < 1) { fprintf(stderr, "kernel_launch: occupancy query gave %d\n", per_cu); per_cu = 1; (void)hipGetLastError(); }
        grid_blocks = cus * per_cu;
    }
    if (grid_blocks < 0) return;
    Params p{};
    for (int i = 0; i < 29; ++i) p.in[i] = (const float*)d_in[i];
    p.out = (float*)d_out; p.ws = (unsigned char*)d_ws;
#if ONE_LAUNCH
    int lo = 0, hi = 8;
    void* args[] = {&p, &lo, &hi};
    hipError_t e = hipLaunchCooperativeKernel((const void*)mk_fwd, dim3(grid_blocks), dim3(512), args, LDS_BYTES, stream);
    if (e != hipSuccess) fprintf(stderr, "cooperative launch failed: %s (grid %d)\n", hipGetErrorString(e), grid_blocks);
#else
    for (int ph = 0; ph < 8; ++ph) hipLaunchKernelGGL(mk_fwd, dim3(grid_blocks), dim3(512), LDS_BYTES, stream, p, ph, ph + 1);
#endif
}
```
